# Optimizing an MI355X kernel written in HIP

```python
import math
import jax, jax.numpy as jnp
from jax import lax
import numpy as np

D_MODEL = 2048
BATCH = 4
SEQ = 2048
DEPTH = 1
DEC_BATCH = 128
DEC_SEQ = 1
PAST_LEN = 16384
PAGE_SIZE = 128

D_MIX = D_MODEL
W_LRU = D_MIX // 2
W_SSD = D_MIX - W_LRU
LRU_HEADS = 16
LRU_BLOCK = W_LRU // LRU_HEADS
LRU_C = 8.0
SSD_HEAD_DIM = 64
SSD_HEADS = W_SSD // SSD_HEAD_DIM
SSD_GROUPS = 2
SSD_HPG = SSD_HEADS // SSD_GROUPS
SSD_STATE = 128
SSD_CHUNK = 128
CONV_W = 4
SSD_CONV_DIM = W_SSD + 2 * SSD_GROUPS * SSD_STATE
IN_COLS = 2 * W_LRU + W_SSD + SSD_CONV_DIM + SSD_HEADS
D_FF = 5632
N_MOD = 9
EPS = 1e-6

kernel_name = "hymba_style_rglru_ssd_macaron_decoder_step"


def rmsnorm(x, g):
    xf = x.astype(jnp.float32)
    y = xf * lax.rsqrt(jnp.mean(xf * xf, axis=-1, keepdims=True) + EPS)
    return (y * g.astype(jnp.float32)).astype(x.dtype)


def modulate(h, shift, scale):
    return h * (1.0 + scale[:, None, :]) + shift[:, None, :]


def swiglu(h, w_up, w_down):
    g, u = jnp.split(h @ w_up, 2, axis=-1)
    return (jax.nn.silu(g) * u) @ w_down


def causal_conv(x, buf, w, b):
    T = x.shape[1]
    xp = jnp.concatenate([buf.astype(x.dtype), x], axis=1)
    y = b
    for k in range(CONV_W):
        y = y + w[k] * xp[:, k:k + T]
    return y, xp[:, xp.shape[1] - (CONV_W - 1):]


def rg_lru(x, h0, w_a, b_a, w_i, b_i, lam):
    Bsz, T, _ = x.shape
    xf = x.astype(jnp.float32)
    xb = xf.reshape(Bsz, T, LRU_HEADS, LRU_BLOCK)
    r = jax.nn.sigmoid(jnp.einsum('bthi,hij->bthj', xb, w_a).reshape(Bsz, T, W_LRU) + b_a)
    i = jax.nn.sigmoid(jnp.einsum('bthi,hij->bthj', xb, w_i).reshape(Bsz, T, W_LRU) + b_i)
    log_a = -LRU_C * r * jax.nn.softplus(-lam.astype(jnp.float32))
    a = jnp.exp(log_a)
    bt = jnp.sqrt(-jnp.expm1(2.0 * log_a)) * (i * xf)

    def combine(e1, e2):
        a1, b1 = e1
        a2, b2 = e2
        return a1 * a2, a2 * b1 + b2

    a_cum, b_cum = lax.associative_scan(combine, (a, bt), axis=1)
    h = a_cum * h0.astype(jnp.float32)[:, None, :] + b_cum
    return h, h[:, -1]


def ssd_scan(x, dt, A, Bm, Cm, h0):
    b, T = x.shape[0], x.shape[1]
    Lc = min(SSD_CHUNK, T)
    pad = (-T) % Lc
    if pad:
        padw = lambda t: jnp.pad(t, [(0, 0), (0, pad)] + [(0, 0)] * (t.ndim - 2))
        x, dt, Bm, Cm = padw(x), padw(dt), padw(Bm), padw(Cm)
    nc = (T + pad) // Lc
    G, E, P, N = SSD_GROUPS, SSD_HPG, SSD_HEAD_DIM, SSD_STATE
    x = x.reshape(b, nc, Lc, G, E, P)
    dt = dt.reshape(b, nc, Lc, G, E)
    Bm = Bm.reshape(b, nc, Lc, G, N)
    Cm = Cm.reshape(b, nc, Lc, G, N)
    dA_cs = jnp.cumsum(dt * A.reshape(G, E), axis=2)
    xdt = x * dt[..., None]
    diff = dA_cs[:, :, :, None] - dA_cs[:, :, None, :]
    causal = jnp.tril(jnp.ones((Lc, Lc), dtype=bool))[:, :, None, None]
    Lmat = jnp.exp(jnp.where(causal, diff, -jnp.inf))
    CB = jnp.einsum('bclgn,bcsgn->bclsg', Cm, Bm)
    M = CB[..., None] * Lmat
    y_diag = jnp.einsum('bclsge,bcsgep->bclgep', M, xdt)
    decay_last = jnp.exp(dA_cs[:, :, -1:] - dA_cs)
    states = jnp.einsum('bclgn,bclge,bclgep->bcgepn', Bm, decay_last, xdt)
    chunk_decay = jnp.exp(dA_cs[:, :, -1])

    def step(h, inp):
        s, d = inp
        return d[..., None, None] * h + s, h

    h_init = h0.astype(jnp.float32).reshape(b, G, E, P, N)
    hT, h_in = lax.scan(step, h_init, (jnp.moveaxis(states, 1, 0), jnp.moveaxis(chunk_decay, 1, 0)))
    h_in = jnp.moveaxis(h_in, 0, 1)
    y_off = jnp.einsum('bclgn,bcgepn,bclge->bclgep', Cm, h_in, jnp.exp(dA_cs))
    y = (y_diag + y_off).reshape(b, nc * Lc, SSD_HEADS, P)[:, :T]
    return y, hT.reshape(b, SSD_HEADS, P, N)


def hybrid_mixer(h, lru_h0, lru_buf0, ssm_h0, ssd_buf0, p):
    Bsz, T, _ = h.shape
    proj = h @ p['w_in']
    o1 = W_LRU
    o2 = o1 + W_LRU
    o3 = o2 + W_SSD
    o4 = o3 + SSD_CONV_DIM
    xl, gl, z, xbc, dt_raw = jnp.split(proj, [o1, o2, o3, o4], axis=-1)
    xl, lru_buf = causal_conv(xl, lru_buf0, p['lru_conv_w'], p['lru_conv_b'])
    hl, lru_hT = rg_lru(xl, lru_h0, p['lru_wa'], p['lru_ba'], p['lru_wi'], p['lru_bi'], p['lru_lambda'])
    out_l = hl * jax.nn.gelu(gl.astype(jnp.float32))
    xbc, ssd_buf = causal_conv(xbc, ssd_buf0, p['ssd_conv_w'], p['ssd_conv_b'])
    xbc = jax.nn.silu(xbc.astype(jnp.float32))
    xs, Bm, Cm = jnp.split(xbc, [W_SSD, W_SSD + SSD_GROUPS * SSD_STATE], axis=-1)
    dt = jax.nn.softplus(dt_raw.astype(jnp.float32) + p['ssd_dt_bias'].astype(jnp.float32))
    A = -jnp.exp(p['ssd_A_log'].astype(jnp.float32))
    xs4 = xs.reshape(Bsz, T, SSD_HEADS, SSD_HEAD_DIM)
    y, ssm_hT = ssd_scan(xs4, dt, A,
                         Bm.reshape(Bsz, T, SSD_GROUPS, SSD_STATE),
                         Cm.reshape(Bsz, T, SSD_GROUPS, SSD_STATE), ssm_h0)
    y = y + p['ssd_D'].astype(jnp.float32)[:, None] * xs4
    y = y.reshape(Bsz, T, W_SSD) * jax.nn.silu(z.astype(jnp.float32))
    y = rmsnorm(y, p['ssd_norm_g'])
    out = jnp.concatenate([out_l, y], axis=-1).astype(h.dtype) @ p['w_out']
    return out, (lru_hT, lru_buf, ssm_hT, ssd_buf)


def decoder_layer(x, c, lru_h0, lru_buf0, ssm_h0, ssd_buf0, p):
    mod = jax.nn.silu(c) @ p['w_ada'] + p['b_ada']
    sh1, sc1, g1, sh2, sc2, g2, sh3, sc3, g3 = jnp.split(mod, N_MOD, axis=-1)
    h = modulate(rmsnorm(x, p['g_ffn1']), sh1, sc1)
    x = x + 0.5 * g1[:, None, :] * swiglu(h, p['w_up1'], p['w_down1'])
    h = modulate(rmsnorm(x, p['g_mix']), sh2, sc2)
    o, new_state = hybrid_mixer(h, lru_h0, lru_buf0, ssm_h0, ssd_buf0, p)
    x = x + g2[:, None, :] * o
    h = modulate(rmsnorm(x, p['g_ffn2']), sh3, sc3)
    x = x + 0.5 * g3[:, None, :] * swiglu(h, p['w_up2'], p['w_down2'])
    return x, new_state


def setup_inputs(seed: int = 0) -> dict:
    key = jax.random.key(seed)
    ks = iter(jax.random.split(key, 48))
    f32 = jnp.float32
    nrm = lambda shape, s: jax.random.normal(next(ks), shape, f32) * s
    L = DEPTH
    u = jax.random.uniform(next(ks), (L, W_LRU), f32, 0.9, 0.999)
    a_base = u ** (1.0 / LRU_C)
    lru_lambda = jnp.log(a_base) - jnp.log1p(-a_base)
    dt0 = jnp.exp(jax.random.uniform(next(ks), (L, SSD_HEADS), f32, math.log(1e-3), math.log(1e-1)))
    ssd_dt_bias = dt0 + jnp.log(-jnp.expm1(-dt0))
    ssd_A_log = jnp.log(jax.random.uniform(next(ks), (L, SSD_HEADS), f32, 1.0, 16.0))
    return {
        'x_prompt': nrm((BATCH, SEQ, D_MODEL), 1.0),
        'x_sample': nrm((DEC_BATCH, DEC_SEQ, D_MODEL), 1.0),
        'c_prompt': nrm((BATCH, D_MODEL), 1.0),
        'c_sample': nrm((DEC_BATCH, D_MODEL), 1.0),
        'state_lru_h': nrm((L, DEC_BATCH, W_LRU), 0.5),
        'state_lru_conv': nrm((L, DEC_BATCH, CONV_W - 1, W_LRU), 1.0),
        'state_ssm': nrm((L, DEC_BATCH, SSD_HEADS, SSD_HEAD_DIM, SSD_STATE), 0.1),
        'state_ssd_conv': nrm((L, DEC_BATCH, CONV_W - 1, SSD_CONV_DIM), 1.0),
        'w_ada': nrm((L, D_MODEL, N_MOD * D_MODEL), 0.5 * D_MODEL ** -0.5),
        'b_ada': nrm((L, N_MOD * D_MODEL), 0.01),
        'g_ffn1': 1.0 + nrm((L, D_MODEL), 0.02),
        'w_up1': nrm((L, D_MODEL, 2 * D_FF), D_MODEL ** -0.5),
        'w_down1': nrm((L, D_FF, D_MODEL), D_FF ** -0.5),
        'g_mix': 1.0 + nrm((L, D_MODEL), 0.02),
        'w_in': nrm((L, D_MODEL, IN_COLS), D_MODEL ** -0.5),
        'lru_conv_w': nrm((L, CONV_W, W_LRU), CONV_W ** -0.5),
        'lru_conv_b': nrm((L, W_LRU), 0.01),
        'lru_wa': nrm((L, LRU_HEADS, LRU_BLOCK, LRU_BLOCK), LRU_BLOCK ** -0.5),
        'lru_ba': nrm((L, W_LRU), 0.01),
        'lru_wi': nrm((L, LRU_HEADS, LRU_BLOCK, LRU_BLOCK), LRU_BLOCK ** -0.5),
        'lru_bi': nrm((L, W_LRU), 0.01),
        'lru_lambda': lru_lambda,
        'ssd_conv_w': nrm((L, CONV_W, SSD_CONV_DIM), CONV_W ** -0.5),
        'ssd_conv_b': nrm((L, SSD_CONV_DIM), 0.01),
        'ssd_dt_bias': ssd_dt_bias,
        'ssd_A_log': ssd_A_log,
        'ssd_D': 1.0 + nrm((L, SSD_HEADS), 0.1),
        'ssd_norm_g': 1.0 + nrm((L, W_SSD), 0.02),
        'w_out': nrm((L, D_MIX, D_MODEL), D_MIX ** -0.5),
        'g_ffn2': 1.0 + nrm((L, D_MODEL), 0.02),
        'w_up2': nrm((L, D_MODEL, 2 * D_FF), D_MODEL ** -0.5),
        'w_down2': nrm((L, D_FF, D_MODEL), D_FF ** -0.5),
        'w_ada_f': nrm((D_MODEL, 2 * D_MODEL), 0.5 * D_MODEL ** -0.5),
        'b_ada_f': nrm((2 * D_MODEL,), 0.01),
        'g_final': 1.0 + nrm((D_MODEL,), 0.02),
    }


def reference(x_prompt, x_sample, c_prompt, c_sample, state_lru_h, state_lru_conv, state_ssm,
              state_ssd_conv, w_ada, b_ada, g_ffn1, w_up1, w_down1, g_mix, w_in, lru_conv_w,
              lru_conv_b, lru_wa, lru_ba, lru_wi, lru_bi, lru_lambda, ssd_conv_w, ssd_conv_b,
              ssd_dt_bias, ssd_A_log, ssd_D, ssd_norm_g, w_out, g_ffn2, w_up2, w_down2,
              w_ada_f, b_ada_f, g_final):
    xp, xs = x_prompt, x_sample
    bp = x_prompt.shape[0]
    dtp = x_prompt.dtype
    new_p = ([], [], [], [])
    new_s = ([], [], [], [])
    for l in range(DEPTH):
        p = {
            'w_ada': w_ada[l], 'b_ada': b_ada[l], 'g_ffn1': g_ffn1[l], 'w_up1': w_up1[l],
            'w_down1': w_down1[l], 'g_mix': g_mix[l], 'w_in': w_in[l],
            'lru_conv_w': lru_conv_w[l], 'lru_conv_b': lru_conv_b[l], 'lru_wa': lru_wa[l],
            'lru_ba': lru_ba[l], 'lru_wi': lru_wi[l], 'lru_bi': lru_bi[l],
            'lru_lambda': lru_lambda[l], 'ssd_conv_w': ssd_conv_w[l], 'ssd_conv_b': ssd_conv_b[l],
            'ssd_dt_bias': ssd_dt_bias[l], 'ssd_A_log': ssd_A_log[l], 'ssd_D': ssd_D[l],
            'ssd_norm_g': ssd_norm_g[l], 'w_out': w_out[l], 'g_ffn2': g_ffn2[l],
            'w_up2': w_up2[l], 'w_down2': w_down2[l],
        }
        xp, sp = decoder_layer(
            xp, c_prompt,
            jnp.zeros((bp, W_LRU), dtp),
            jnp.zeros((bp, CONV_W - 1, W_LRU), dtp),
            jnp.zeros((bp, SSD_HEADS, SSD_HEAD_DIM, SSD_STATE), dtp),
            jnp.zeros((bp, CONV_W - 1, SSD_CONV_DIM), dtp), p)
        xs, ss = decoder_layer(xs, c_sample, state_lru_h[l], state_lru_conv[l], state_ssm[l],
                               state_ssd_conv[l], p)
        for j in range(4):
            new_p[j].append(sp[j])
            new_s[j].append(ss[j])

    def final(x, c):
        shf, scf = jnp.split(jax.nn.silu(c) @ w_ada_f + b_ada_f, 2, axis=-1)
        return modulate(rmsnorm(x, g_final), shf, scf)

    y_prompt = final(xp, c_prompt).astype(x_prompt.dtype)
    y_sample = final(xs, c_sample).astype(x_sample.dtype)
    lru_h_prompt = jnp.stack(new_p[0]).astype(state_lru_h.dtype)
    lru_conv_prompt = jnp.stack(new_p[1]).astype(state_lru_conv.dtype)
    ssm_prompt = jnp.stack(new_p[2]).astype(state_ssm.dtype)
    ssd_conv_prompt = jnp.stack(new_p[3]).astype(state_ssd_conv.dtype)
    lru_h_sample = jnp.stack(new_s[0]).astype(state_lru_h.dtype)
    lru_conv_sample = jnp.stack(new_s[1]).astype(state_lru_conv.dtype)
    ssm_sample = jnp.stack(new_s[2]).astype(state_ssm.dtype)
    ssd_conv_sample = jnp.stack(new_s[3]).astype(state_ssd_conv.dtype)
    return (y_prompt, y_sample, lru_h_prompt, lru_conv_prompt, ssm_prompt, ssd_conv_prompt,
            lru_h_sample, lru_conv_sample, ssm_sample, ssd_conv_sample)
```

```cpp
#include <hip/hip_runtime.h>
#include <hip/hip_cooperative_groups.h>
#include <cstdio>
#include <cstdint>
namespace cg = cooperative_groups;

namespace pg8 {
#define PG8_LAS __attribute__((address_space(3)))
typedef unsigned short bf16_t;
typedef short bf16x8 __attribute__((ext_vector_type(8)));
typedef float f32x4 __attribute__((ext_vector_type(4)));
typedef unsigned u32x4 __attribute__((ext_vector_type(4)));
constexpr int BM = 256, BK = 64, HALF = 128, HTB = HALF * BK * 2, STAGE_BYTES = 8 * HTB, NXCD = 8, WGM = 8;

__host__ __device__ __forceinline__ int lds_byte(int r, int c) { const int st = (r >> 4) * 2 + (c >> 5), rr = r & 15, cc = c & 31, ob = rr * 64 + cc * 2; return st * 1024 + (ob ^ (((ob >> 9) & 1) << 5)); }
__host__ __device__ __forceinline__ void stage_rc(int b, int& R, int& C) { const int st = b / 1024, sb = b % 1024, swz = sb ^ (((sb >> 9) & 1) << 5); R = (st >> 1) * 16 + swz / 64; C = (st & 1) * 32 + (swz % 64) / 2; }
__host__ __device__ __forceinline__ int perm32(int rho) { const int n = rho >> 4, i = rho & 15; return 8 * (i >> 2) + 4 * n + (i & 3); }

struct Unit { int pm, pn, ko; };
struct Gemm { const bf16_t* A; const bf16_t* Bt; int lda, ldb, K; };

struct StaticOrder {
    int nM, nN, nwg, G, c; unsigned* flag; unsigned want;
    __device__ void init(int nM_, int nN_, int G_, int c_, unsigned* flag_ = nullptr, unsigned want_ = 0) { nM = nM_; nN = nN_; nwg = nM * nN; G = G_; c = c_; flag = flag_; want = want_; }
    __device__ __forceinline__ void a_ready(const Unit& u) const {
        if (flag && u.pm == 32) { unsigned sp = 0; while ((unsigned)__builtin_amdgcn_readfirstlane(__hip_atomic_load(flag, __ATOMIC_RELAXED, __HIP_MEMORY_SCOPE_AGENT)) < want) { __builtin_amdgcn_s_sleep(4); if (++sp > (1u << 22)) break; } asm volatile("s_waitcnt vmcnt(0)" ::: "memory"); }
    }
    __device__ bool next(int i, Unit& u) const {
        const long L = (long)i * G + c; if (L >= nwg) return false;
        int wgid = (int)L; { const int q = nwg / NXCD, r = nwg % NXCD, xcd = wgid % NXCD, off = wgid / NXCD; wgid = (xcd < r ? xcd * (q + 1) : r * (q + 1) + (xcd - r) * q) + off; }
        const int nig = WGM * nN, gid = wgid / nig, fm = gid * WGM, gsz = (nM - fm) < WGM ? (nM - fm) : WGM;
        u.pm = fm + ((wgid % nig) % gsz); u.pn = (wgid % nig) / gsz; u.ko = 0; return true;
    }
};

__device__ __forceinline__ unsigned cvt_pk_bf16(float lo, float hi) { unsigned r; asm volatile("v_cvt_pk_bf16_f32 %0, %1, %2" : "=v"(r) : "v"(lo), "v"(hi)); return r; }

template <class Epi, class Sched>
__device__ __forceinline__ void gemm_phase(PG8_LAS unsigned char* lds, const Gemm g, const Sched& S, const Epi& E) {
    int tid = threadIdx.x; asm volatile("" : "+v"(tid));
    const int wid = __builtin_amdgcn_readfirstlane(tid >> 6), lane = tid & 63, wr = wid >> 2, wc = wid & 3, fr = lane & 15, fq = lane >> 4;
    const int nt = g.K / BK;
    unsigned voffA[2], voffB[2];
#pragma unroll
    for (int i = 0; i < 2; ++i) { int R, C; stage_rc(tid * 16 + i * 8192, R, C); const int Rb = Epi::PERM ? ((R & ~31) + perm32(R & 31)) : R;
        voffA[i] = (unsigned)(R * g.lda + C) * 2u; voffB[i] = (unsigned)(Rb * g.ldb + C) * 2u; }
    const size_t kstep = (size_t)(BK * 2);
    const size_t hstepA = (size_t)HALF * g.lda * 2, hstepB = (size_t)HALF * g.ldb * 2;
    const size_t tstepA = 2 * hstepA, tstepB = 2 * hstepB;
    const unsigned ldsw = (unsigned)wid * 1024u;
    const int aoff = lds_byte(wr * 64 + fr, fq * 8), boff = lds_byte(wc * 32 + fr, fq * 8);
#define PG8_SA(b, h) (((b) * 2 + (h)) * HTB)
#define PG8_SB(b, h) ((4 + (b) * 2 + (h)) * HTB)
#define PG8_STAGE(bufoff, gbase, voff) do { _Pragma("unroll") for (int _i = 0; _i < 2; ++_i) \
        __builtin_amdgcn_global_load_lds((const unsigned*)((const char*)(gbase) + (voff)[_i]), (PG8_LAS unsigned*)(lds + (bufoff) + ldsw + _i * 8192), 16, 0, 0); } while (0)
#define PG8_LDA(dst, b, h) do { _Pragma("unroll") for (int m = 0; m < 4; ++m) _Pragma("unroll") for (int k = 0; k < 2; ++k) dst[m][k] = *(const PG8_LAS bf16x8*)(lds + PG8_SA(b, h) + aoff + m * 2048 + k * 1024); } while (0)
#define PG8_LDB(dst, b, h) do { _Pragma("unroll") for (int n = 0; n < 2; ++n) _Pragma("unroll") for (int k = 0; k < 2; ++k) dst[n][k] = *(const PG8_LAS bf16x8*)(lds + PG8_SB(b, h) + boff + n * 2048 + k * 1024); } while (0)
#define PG8_MMA(ai, bj, At, Bt) do { __builtin_amdgcn_s_setprio(1); _Pragma("unroll") for (int m = 0; m < 4; ++m) { if (Epi::MTRIM && (ai) == 1 && (m > 0 || wr == 1)) continue; \
        _Pragma("unroll") for (int n = 0; n < 2; ++n) _Pragma("unroll") for (int k = 0; k < 2; ++k) \
        acc[ai][bj][m][n] = __builtin_amdgcn_mfma_f32_16x16x32_bf16(Bt[n][k], At[m][k], acc[ai][bj][m][n], 0, 0, 0); } __builtin_amdgcn_s_setprio(0); } while (0)
#define PG8_WAIT_V(n) asm volatile("s_waitcnt vmcnt(" #n ")" ::: "memory")
#define PG8_WAIT_L(n) asm volatile("s_waitcnt lgkmcnt(" #n ")" ::: "memory")
#define PG8_BAR __builtin_amdgcn_s_barrier()
#define PG8_SCHED __builtin_amdgcn_sched_barrier(0)
    Unit cur, nxt; int ui = 0;
    if (!S.next(0, cur)) return;
    f32x4 acc[2][2][4][2];
#pragma unroll
    for (int a = 0; a < 2; ++a)
#pragma unroll
        for (int b = 0; b < 2; ++b)
#pragma unroll
            for (int m = 0; m < 4; ++m)
#pragma unroll
                for (int n = 0; n < 2; ++n) acc[a][b][m][n] = (f32x4){0.f, 0.f, 0.f, 0.f};
    bf16x8 At[4][2], B0[2][2], B1[2][2];
    const char* cA = (const char*)g.A + (size_t)cur.pm * tstepA + (size_t)cur.ko * 2; const char* cB = (const char*)g.Bt + (size_t)cur.pn * tstepB + (size_t)cur.ko * 2;
    S.a_ready(cur);
    PG8_STAGE(PG8_SB(0, 0), cB, voffB); PG8_STAGE(PG8_SB(0, 1), cB + hstepB, voffB); PG8_STAGE(PG8_SA(0, 0), cA, voffA); PG8_STAGE(PG8_SA(0, 1), cA + hstepA, voffA);
    if (wr == 1) PG8_BAR;
    PG8_WAIT_V(2); PG8_BAR;
    PG8_STAGE(PG8_SB(1, 0), cB + kstep, voffB); PG8_STAGE(PG8_SA(1, 0), cA + kstep, voffA); PG8_STAGE(PG8_SB(1, 1), cB + hstepB + kstep, voffB);
    PG8_WAIT_V(6); PG8_BAR;
    for (;;) {
        const bool has_next = S.next(ui + 1, nxt);
        const char* nA = has_next ? (const char*)g.A + (size_t)nxt.pm * tstepA + (size_t)nxt.ko * 2 : cA; const char* nB = has_next ? (const char*)g.Bt + (size_t)nxt.pn * tstepB + (size_t)nxt.ko * 2 : cB;
        for (int t = 0; t < nt; t += 2) {
            const bool last = (t == nt - 2);
            if constexpr (Epi::MIDSCALE) { if (t == 16) E.midscale(acc, cur, wr, fr); }
            const char* a1 = cA + (size_t)(t + 1) * kstep;
            const char* a2 = last ? nA : cA + (size_t)(t + 2) * kstep; const char* b2 = last ? nB : cB + (size_t)(t + 2) * kstep;
            const char* a3 = a2 + kstep; const char* b3 = b2 + kstep;
            if (last && has_next) S.a_ready(nxt);
            PG8_LDB(B0, 0, 0); PG8_LDB(B1, 0, 1); PG8_SCHED; PG8_LDA(At, 0, 0); PG8_STAGE(PG8_SA(1, 1), a1 + hstepA, voffA);
            PG8_WAIT_V(8); PG8_WAIT_L(0); PG8_BAR; PG8_MMA(0, 0, At, B0); PG8_MMA(0, 1, At, B1); PG8_BAR; PG8_SCHED;
            PG8_LDA(At, 0, 1); PG8_STAGE(PG8_SB(0, 0), b2, voffB); PG8_STAGE(PG8_SB(0, 1), b2 + hstepB, voffB); PG8_STAGE(PG8_SA(0, 0), a2, voffA);
            PG8_WAIT_V(8); PG8_WAIT_L(0); PG8_BAR; PG8_MMA(1, 0, At, B0); PG8_MMA(1, 1, At, B1); PG8_BAR; PG8_SCHED;
            PG8_LDB(B0, 1, 0); PG8_LDB(B1, 1, 1); PG8_SCHED; PG8_LDA(At, 1, 0); PG8_STAGE(PG8_SA(0, 1), a2 + hstepA, voffA);
            PG8_WAIT_V(8); PG8_WAIT_L(0); PG8_BAR; PG8_MMA(0, 0, At, B0); PG8_MMA(0, 1, At, B1); PG8_BAR; PG8_SCHED;
            PG8_LDA(At, 1, 1); PG8_STAGE(PG8_SB(1, 0), b3, voffB); PG8_STAGE(PG8_SB(1, 1), b3 + hstepB, voffB); PG8_STAGE(PG8_SA(1, 0), a3, voffA);
            PG8_WAIT_V(8); PG8_WAIT_L(0); PG8_BAR; PG8_MMA(1, 0, At, B0); PG8_MMA(1, 1, At, B1); PG8_BAR; PG8_SCHED;
        }
        if (wr == 0) PG8_BAR;
        E(acc, cur, wr, wc, fr, fq);
        if (!has_next) break;
#pragma unroll
        for (int a = 0; a < 2; ++a)
#pragma unroll
            for (int b = 0; b < 2; ++b)
#pragma unroll
                for (int m = 0; m < 4; ++m)
#pragma unroll
                    for (int n = 0; n < 2; ++n) acc[a][b][m][n] = (f32x4){0.f, 0.f, 0.f, 0.f};
        cur = nxt; cA = nA; cB = nB; ++ui;
        if (wr == 1) PG8_BAR;
    }
    PG8_WAIT_V(0);
    PG8_BAR;
#undef PG8_SA
#undef PG8_SB
#undef PG8_STAGE
#undef PG8_LDA
#undef PG8_LDB
#undef PG8_MMA
#undef PG8_WAIT_V
#undef PG8_WAIT_L
#undef PG8_BAR
#undef PG8_SCHED
}
}

using pg8::bf16_t; using pg8::bf16x8; using pg8::f32x4; using pg8::u32x4;
typedef float f32x2 __attribute__((ext_vector_type(2)));
typedef unsigned u32x2 __attribute__((ext_vector_type(2)));

constexpr int D = 2048, TP = 8192, SEQ = 2048, NB = 4, NS = 128, MV = TP + NS  , MP = 8448  ;
constexpr int FF = 5632, WL = 1024, WS_ = 1024, NH = 16, HP = 64, NST = 128, CONVD = 1536, INC = 4624, INCP = 4864;
constexpr int NMOD = 22528;
constexpr float EPS = 1e-6f;
constexpr int NCH = 16;
constexpr int PC_XL = 0, PC_GL = 1024, PC_Z = 2048, PC_XBC = 3072, PC_DT = 4608;
constexpr size_t O_YP = 0, O_YS = 16777216, O_LHP = 17039360, O_LCP = 17043456, O_SSMP = 17055744, O_SCP = 17580032,
                 O_LHS = 17598464, O_LCS = 17729536, O_SSMS = 18122752, O_SCS = 34899968, O_END = 35489792;
constexpr size_t SZ_WUP = (size_t)2 * FF * D * 2, SZ_WDN = (size_t)D * FF * 2;
constexpr size_t WS_WUP1 = 0, WS_WDN1 = WS_WUP1 + SZ_WUP, WS_WUP2 = WS_WDN1 + SZ_WDN, WS_WDN2 = WS_WUP2 + SZ_WUP;
constexpr size_t WS_WIN = WS_WDN2 + SZ_WDN, WS_WOUT = WS_WIN + (size_t)INCP * D * 2, WS_WAT = WS_WOUT + (size_t)D * D * 2, WS_WIT = WS_WAT + 131072;
constexpr size_t WS_CACT = WS_WIT + 131072, WS_MOD = WS_CACT + (size_t)256 * D * 2, WS_H = WS_MOD + (size_t)2 * 256 * NMOD * 4;
constexpr size_t MODB = (size_t)256 * NMOD;
constexpr size_t WS_X = WS_H + (size_t)MP * D * 2, WS_BIG = WS_X + (size_t)MP * D * 4, WS_ADA = WS_BIG + (size_t)MP * INCP * 4;
constexpr size_t WS_ST = WS_ADA + (size_t)NMOD * D * 2, WS_SMALL = WS_ST + (size_t)NB * NCH * NH * HP * NST * 4;
constexpr size_t WS_CS = WS_SMALL, WS_SSQ = WS_CS + (size_t)MP * 16 * 4, WS_AGA = WS_SSQ + (size_t)MP * 16 * 4, WS_AGB = WS_AGA + 262144, WS_CD = WS_AGB + 262144, WS_CTL = WS_CD + 4096, WS_PART = WS_CTL + 16384, WS_RS = WS_PART + (size_t)22 * 128 * D * 4, WS_RSSQ = WS_RS + 3 * 40960, WS_END = WS_RSSQ + (size_t)MP * 4;
constexpr int KSPL = 256;
constexpr size_t WS_YPART = WS_WUP1;
constexpr size_t WS_GLB = WS_ADA + (size_t)MP * 1024 * 2, WS_ZB = WS_ADA + (size_t)MP * 1024 * 6;
constexpr size_t WS_ACUM = WS_ADA, WS_HLOC = WS_ACUM + (size_t)MP * 1024 * 4, WS_XS = WS_HLOC + (size_t)MP * 1024 * 4, WS_CACT2 = WS_XS + (size_t)MP * 1024 * 2;
static_assert(WS_CACT2 + (size_t)MP * 256 * 2 <= WS_ST, "ada region overlay");
static_assert((size_t)MP * FF * 2 <= (size_t)MP * INCP * 4, "act fits in big");

__device__ __forceinline__ unsigned pk2(float lo, float hi) { unsigned r; asm("v_cvt_pk_bf16_f32 %0, %1, %2" : "=v"(r) : "v"(lo), "v"(hi)); return r; }
__device__ __forceinline__ unsigned f2bf(float f) { return pk2(f, 0.f); }
__device__ __forceinline__ float bf2f(unsigned h) { return __builtin_bit_cast(float, h << 16); }
__device__ __forceinline__ float sigm(float x) { return __builtin_amdgcn_rcpf(1.f + __expf(-x)); }
__device__ __forceinline__ float siluf(float x) { return x * __builtin_amdgcn_rcpf(1.f + __expf(-x)); }
__device__ __forceinline__ float softplusf(float x) { return x > 20.f ? x : log1pf(expf(x)); }
__device__ __forceinline__ float gelu_tanh(float x) { const float u = 0.7978845608028654f * (x + 0.044715f * x * x * x); return 0.5f * x * (1.f + tanhf(u)); }
__device__ __forceinline__ float wave_sum(float v) {
#pragma unroll
    for (int o = 1; o < 64; o <<= 1) v += __shfl_xor(v, o);
    return v;
}
__device__ __forceinline__ int batch_row(int row) { return row < TP ? (row >> 11) : (NB + row - TP); }

struct EpiSwiGLU {
    static constexpr bool MIDSCALE = false, MTRIM = false;
    static constexpr bool PERM = true;
    bf16_t* O;
    __device__ __forceinline__ void operator()(f32x4 (&acc)[2][2][4][2], const pg8::Unit& u, int wr, int wc, int fr, int fq) const {
        const int row0 = u.pm * 256 + wr * 64 + fr, col0 = u.pn * 128 + wc * 32 + 8 * fq;
#pragma unroll
        for (int ai = 0; ai < 2; ++ai)
#pragma unroll
            for (int m = 0; m < 4; ++m) {
                bf16_t* rowp = O + (size_t)(row0 + ai * 128 + m * 16) * FF + col0;
                float o[8];
#pragma unroll
                for (int n = 0; n < 2; ++n)
#pragma unroll
                    for (int j = 0; j < 4; ++j) { const float gv = acc[ai][0][m][n][j], uv = acc[ai][1][m][n][j]; o[n * 4 + j] = gv * __builtin_amdgcn_rcpf(1.f + __expf(-gv)) * uv; }
                u32x4 w; w.x = pg8::cvt_pk_bf16(o[0], o[1]); w.y = pg8::cvt_pk_bf16(o[2], o[3]); w.z = pg8::cvt_pk_bf16(o[4], o[5]); w.w = pg8::cvt_pk_bf16(o[6], o[7]);
                *(u32x4*)rowp = w;
            }
    }
};
struct EpiRes {
    static constexpr bool MIDSCALE = false, MTRIM = false;
    static constexpr bool PERM = false;
    const float* base_p; const float* base_s; float* out; const float* gate; float s;
    __device__ __forceinline__ void operator()(f32x4 (&acc)[2][2][4][2], const pg8::Unit& u, int wr, int wc, int fr, int fq) const {
        const int col0 = u.pn * 256 + wc * 32 + 4 * fq;
#pragma unroll
        for (int ai = 0; ai < 2; ++ai)
#pragma unroll
            for (int m = 0; m < 4; ++m) {
                const int row = u.pm * 256 + ai * 128 + wr * 64 + m * 16 + fr;
                if (row < MV) {
                    const float* bp = row < TP ? base_p + (size_t)row * D : base_s + (size_t)(row - TP) * D;
                    const float* gp = gate + (size_t)batch_row(row) * NMOD;
                    float* op = out + (size_t)row * D;
#pragma unroll
                    for (int bj = 0; bj < 2; ++bj)
#pragma unroll
                        for (int n = 0; n < 2; ++n) { const int c = col0 + bj * 128 + n * 16;
                            const f32x4 b = *(const f32x4*)(bp + c), gg = *(const f32x4*)(gp + c) + *(const f32x4*)(gp + MODB + c);
                            *(f32x4*)(op + c) = b + (gg * s) * acc[ai][bj][m][n]; }
                }
            }
    }
};
struct EpiProj {
    static constexpr bool PERM = false, MIDSCALE = false, MTRIM = false;
    float* out; bf16_t* glb; bf16_t* zb;
    __device__ __forceinline__ void operator()(f32x4 (&acc)[2][2][4][2], const pg8::Unit& u, int wr, int wc, int fr, int fq) const {
        const int colt = wc * 32 + 4 * fq;
        if (u.pn >= 4 && u.pn < 12) {
            bf16_t* ob = (u.pn < 8 ? glb : zb) + (u.pn & 3) * 256 + colt;
#pragma unroll
            for (int ai = 0; ai < 2; ++ai)
#pragma unroll
                for (int m = 0; m < 4; ++m) { const int row = u.pm * 256 + ai * 128 + wr * 64 + m * 16 + fr;
                    if (row < MV) { bf16_t* op = ob + (size_t)row * 1024;
#pragma unroll
                        for (int bj = 0; bj < 2; ++bj)
#pragma unroll
                            for (int n = 0; n < 2; ++n) { const f32x4 v = acc[ai][bj][m][n]; u32x2 o; o.x = pk2(v.x, v.y); o.y = pk2(v.z, v.w); *(u32x2*)(op + bj * 128 + n * 16) = o; } } }
        } else {
            const int col0 = u.pn * 256 + colt;
#pragma unroll
            for (int ai = 0; ai < 2; ++ai)
#pragma unroll
                for (int m = 0; m < 4; ++m) { const int row = u.pm * 256 + ai * 128 + wr * 64 + m * 16 + fr;
                    if (row < MV) { float* op = out + (size_t)row * INCP + col0;
#pragma unroll
                        for (int bj = 0; bj < 2; ++bj)
#pragma unroll
                            for (int n = 0; n < 2; ++n) *(f32x4*)(op + bj * 128 + n * 16) = acc[ai][bj][m][n]; } }
        }
    }
};
struct EpiF32 {
    static constexpr bool MIDSCALE = false, MTRIM = false;
    static constexpr bool PERM = false;
    float* out; int ldc; int mvalid; const float* bias1; const float* bias2; int split;
    __device__ __forceinline__ void operator()(f32x4 (&acc)[2][2][4][2], const pg8::Unit& u, int wr, int wc, int fr, int fq) const {
        const int col0 = u.pn * 256 + wc * 32 + 4 * fq;
        f32x4 bv[2][2];
#pragma unroll
        for (int bj = 0; bj < 2; ++bj)
#pragma unroll
            for (int n = 0; n < 2; ++n) { const int c = col0 + bj * 128 + n * 16;
                bv[bj][n] = bias1 ? (c < split ? *(const f32x4*)(bias1 + c) : *(const f32x4*)(bias2 + (c - split))) : (f32x4){0.f, 0.f, 0.f, 0.f}; }
#pragma unroll
        for (int ai = 0; ai < 2; ++ai)
#pragma unroll
            for (int m = 0; m < 4; ++m) {
                const int row = u.pm * 256 + ai * 128 + wr * 64 + m * 16 + fr;
                if (row < mvalid) {
                    float* op = out + (size_t)row * ldc;
#pragma unroll
                    for (int bj = 0; bj < 2; ++bj)
#pragma unroll
                        for (int n = 0; n < 2; ++n) *(f32x4*)(op + col0 + bj * 128 + n * 16) = acc[ai][bj][m][n] + bv[bj][n];
                }
            }
    }
};

template <bool FINAL, bool MID = false>
struct EpiResNorm {
    static constexpr bool PERM = false, MIDSCALE = MID, MTRIM = false;
    __device__ __forceinline__ void midscale(f32x4 (&acc)[2][2][4][2], const pg8::Unit& u, int wr, int fr) const {
        asm volatile("" : "+v"(fr));
#pragma unroll
        for (int ai = 0; ai < 2; ++ai)
#pragma unroll
            for (int m = 0; m < 4; ++m) { const float* rssq = rs + (WS_RSSQ - (WS_RS + 40960)) / 4;
                const float r = rsqrtf(rssq[u.pm * 256 + ai * 128 + wr * 64 + m * 16 + fr] * (1.f / 1024.f) + EPS);
#pragma unroll
                for (int bj = 0; bj < 2; ++bj)
#pragma unroll
                    for (int n = 0; n < 2; ++n) acc[ai][bj][m][n] = acc[ai][bj][m][n] * r; }
    }
    const float* base; float* X; const float* mod; int g_off; float s; const float* gw; int sh_off, sc_off; bf16_t* H; float* out; float* rs; unsigned* cnt;
    __device__ __forceinline__ void operator()(f32x4 (&acc)[2][2][4][2], const pg8::Unit& u, int wr, int wc, int fr, int fq) const {
        const int col0 = u.pn * 256 + wc * 32 + 4 * fq, row0 = u.pm * 256 + wr * 64 + fr;
        const float* mr = mod + (size_t)(row0 >> 11) * NMOD;
#pragma unroll
        for (int bj = 0; bj < 2; ++bj)
#pragma unroll
            for (int n = 0; n < 2; ++n) { const int c = col0 + bj * 128 + n * 16;
                const f32x4 gg = (*(const f32x4*)(mr + g_off + c) + *(const f32x4*)(mr + MODB + g_off + c)) * s;
#pragma unroll
                for (int ai = 0; ai < 2; ++ai)
#pragma unroll
                    for (int m = 0; m < 4; ++m) { const size_t off = (size_t)(row0 + ai * 128 + m * 16) * D + c; acc[ai][bj][m][n] = *(const f32x4*)(base + off) + gg * acc[ai][bj][m][n]; }
                asm volatile("" : "+v"(acc[0][bj][0][n]), "+v"(acc[0][bj][1][n]), "+v"(acc[0][bj][2][n]), "+v"(acc[0][bj][3][n]), "+v"(acc[1][bj][0][n]), "+v"(acc[1][bj][1][n]), "+v"(acc[1][bj][2][n]), "+v"(acc[1][bj][3][n]) :: "memory"); }
#pragma unroll
        for (int ai = 0; ai < 2; ++ai)
#pragma unroll
            for (int m = 0; m < 4; ++m) { float q = 0.f;
#pragma unroll
                for (int bj = 0; bj < 2; ++bj)
#pragma unroll
                    for (int n = 0; n < 2; ++n) { const f32x4 v = acc[ai][bj][m][n]; q += (v.x * v.x + v.y * v.y) + (v.z * v.z + v.w * v.w); }
                q += __shfl_xor(q, 16); q += __shfl_xor(q, 32);
                if (fq == 0) __hip_atomic_fetch_add(rs + row0 + ai * 128 + m * 16, q, __ATOMIC_RELAXED, __HIP_MEMORY_SCOPE_AGENT); }
        asm volatile("s_waitcnt vmcnt(0)" ::: "memory");
        unsigned* pc = cnt + 64 * u.pm;
        if ((threadIdx.x & 63) == 0) __hip_atomic_fetch_add(pc, 1u, __ATOMIC_RELAXED, __HIP_MEMORY_SCOPE_AGENT);
        { unsigned sp = 0; while ((unsigned)__builtin_amdgcn_readfirstlane(__hip_atomic_load(pc, __ATOMIC_RELAXED, __HIP_MEMORY_SCOPE_AGENT)) < 64u) { __builtin_amdgcn_s_sleep(2); if (++sp > (1u << 20)) break; } }
        asm volatile("s_waitcnt vmcnt(0)" ::: "memory");
        float rstd[2][4];
#pragma unroll
        for (int ai = 0; ai < 2; ++ai)
#pragma unroll
            for (int m = 0; m < 4; ++m) rstd[ai][m] = rsqrtf(__hip_atomic_load(rs + row0 + ai * 128 + m * 16, __ATOMIC_RELAXED, __HIP_MEMORY_SCOPE_AGENT) * (1.f / D) + EPS);
#pragma unroll
        for (int bj = 0; bj < 2; ++bj)
#pragma unroll
            for (int n = 0; n < 2; ++n) { const int c = col0 + bj * 128 + n * 16;
                const f32x4 gg = *(const f32x4*)(gw + c), sc1 = (*(const f32x4*)(mr + sc_off + c) + *(const f32x4*)(mr + MODB + sc_off + c)) + 1.f, sh = *(const f32x4*)(mr + sh_off + c) + *(const f32x4*)(mr + MODB + sh_off + c);
                const f32x4 gs = gg * sc1;
#pragma unroll
                for (int ai = 0; ai < 2; ++ai)
#pragma unroll
                    for (int m = 0; m < 4; ++m) { const size_t off = (size_t)(row0 + ai * 128 + m * 16) * D + c;
                        const f32x4 xv = acc[ai][bj][m][n];
                        const f32x4 y = (xv * rstd[ai][m]) * gs + sh;
                        if (FINAL) *(f32x4*)(out + off) = y;
                        else { *(f32x4*)(X + off) = xv; u32x2 o; o.x = pk2(y.x, y.y); o.y = pk2(y.z, y.w); *(u32x2*)(H + off) = o; } }
                asm volatile("" ::: "memory"); }
    }
};
struct ModSplitOrder {
    int G, c;
    __device__ __forceinline__ void a_ready(const pg8::Unit&) const {}
    __device__ bool next(int i, pg8::Unit& u) const { const int j = i * G + c; if (j >= 176) return false; u.pm = 0; u.pn = j % 88; u.ko = (j / 88) * 1024; return true; }
};
struct EpiMod {
    static constexpr bool MIDSCALE = false, MTRIM = true;
    static constexpr bool PERM = false;
    float* out; const float* bias1; const float* bias2;
    __device__ __forceinline__ void operator()(f32x4 (&acc)[2][2][4][2], const pg8::Unit& u, int wr, int wc, int fr, int fq) const {
        const int col0 = u.pn * 256 + wc * 32 + 4 * fq; float* ob = out + (u.ko ? MODB : 0);
        f32x4 bv[2][2];
#pragma unroll
        for (int bj = 0; bj < 2; ++bj)
#pragma unroll
            for (int n = 0; n < 2; ++n) { const int c = col0 + bj * 128 + n * 16;
                bv[bj][n] = u.ko == 0 ? (c < 18432 ? *(const f32x4*)(bias1 + c) : *(const f32x4*)(bias2 + (c - 18432))) : (f32x4){0.f, 0.f, 0.f, 0.f}; }
#pragma unroll
        for (int ai = 0; ai < 2; ++ai)
#pragma unroll
            for (int m = 0; m < 4; ++m) {
                const int row = ai * 128 + wr * 64 + m * 16 + fr;
                if (row < NB + NS) { float* op = ob + (size_t)row * NMOD;
#pragma unroll
                    for (int bj = 0; bj < 2; ++bj)
#pragma unroll
                        for (int n = 0; n < 2; ++n) *(f32x4*)(op + col0 + bj * 128 + n * 16) = acc[ai][bj][m][n] + bv[bj][n]; }
            }
    }
};
struct SampleSplitOrder {
    int n, G, c, KS;
    __device__ __forceinline__ void a_ready(const pg8::Unit&) const {}
    __device__ void init(int nsplit, int KS_, int G_, int c_) { n = 8 * nsplit; G = G_; c = c_; KS = KS_; }
    __device__ bool next(int i, pg8::Unit& u) const { const int j = i * G + c; if (j >= n) return false; u.pm = 32; u.pn = j & 7; u.ko = (j >> 3) * KS; return true; }
};
struct EpiPart {
    static constexpr bool MIDSCALE = false, MTRIM = false;
    static constexpr bool PERM = false;
    float* part; const float* gate; float s; int KS; int ssd_scale = 0;
    __device__ __forceinline__ void operator()(f32x4 (&acc)[2][2][4][2], const pg8::Unit& u, int wr, int wc, int fr, int fq) const {
        const int col0 = u.pn * 256 + wc * 32 + 4 * fq, ks = u.ko / KS;
#pragma unroll
        for (int m = 0; m < 4; ++m) {
            const int rl = wr * 64 + m * 16 + fr;
            const float* gp = gate + (size_t)(NB + rl) * NMOD; float* op = part + ((size_t)ks * 128 + rl) * D;
            const float sr = (ssd_scale && u.ko < 1024) ? s * rsqrtf((part + (WS_RSSQ - WS_PART) / 4)[TP + rl] * (1.f / 1024.f) + EPS) : s;
#pragma unroll
            for (int bj = 0; bj < 2; ++bj)
#pragma unroll
                for (int n = 0; n < 2; ++n) { const int c = col0 + bj * 128 + n * 16; const f32x4 gg = *(const f32x4*)(gp + c) + *(const f32x4*)(gp + MODB + c); *(f32x4*)(op + c) = (gg * sr) * acc[0][bj][m][n]; }
        }
    }
};

struct Args { const float* in[35]; float* out; unsigned char* ws; int never; int pad; };
constexpr int ARGTAB_OFF = 131072 + 1024;
struct AP {
    const unsigned* tab;
    __device__ __forceinline__ unsigned long long raw(int i) const { const unsigned lo = __builtin_amdgcn_readfirstlane(tab[2 * i]), hi = __builtin_amdgcn_readfirstlane(tab[2 * i + 1]); return ((unsigned long long)hi << 32) | lo; }
    __device__ __forceinline__ const float* in(int i) const { return (const float*)raw(i); }
    __device__ __forceinline__ float* out() const { return (float*)raw(35); }
    __device__ __forceinline__ unsigned char* ws() const { return (unsigned char*)raw(36); }
};
enum { I_XP = 0, I_XS, I_CP, I_CS, I_SLH, I_SLC, I_SSM, I_SSC, I_WADA, I_BADA, I_GF1, I_WUP1, I_WDN1, I_GMIX, I_WIN, I_LCW, I_LCB, I_LWA, I_LBA, I_LWI, I_LBI,
       I_LLAM, I_SCW, I_SCB, I_DTB, I_ALOG, I_SD, I_SNG, I_WOUT, I_GF2, I_WUP2, I_WDN2, I_WADAF, I_BADAF, I_GFIN };

__device__ __forceinline__ void p0_item(const float* W, int K, int N, bf16_t* WT, int k0, int n0, int drow0, float* scr, int lane, int kdst = -1) {
    if (kdst < 0) kdst = k0;
    const int nn = n0 + (lane & 31); const bool ok = nn < N;
    float rv[32];
    const float* wp = W + (size_t)(k0 + (lane >> 5)) * N + (ok ? nn : 0);
#pragma unroll
    for (int i = 0; i < 32; ++i) rv[i] = __builtin_nontemporal_load(wp + (size_t)(2 * i) * N);
#pragma unroll
    for (int i = 0; i < 32; ++i) { const int kk = 2 * i + (lane >> 5); scr[kk * 33 + (lane & 31)] = ok ? rv[i] : 0.f; }
    asm volatile("s_waitcnt lgkmcnt(0)" ::: "memory");
    const int c = lane & 7;
#pragma unroll
    for (int j = 0; j < 4; ++j) { const int n = (lane >> 3) + 8 * j; const float* s = scr + (8 * c) * 33 + n;
        u32x4 o; o.x = pk2(s[0 * 33], s[1 * 33]); o.y = pk2(s[2 * 33], s[3 * 33]); o.z = pk2(s[4 * 33], s[5 * 33]); o.w = pk2(s[6 * 33], s[7 * 33]);
        if (n0 + n < N) *(u32x4*)(WT + (size_t)(drow0 + n) * K + kdst + 8 * c) = o; }
    asm volatile("s_waitcnt lgkmcnt(0)" ::: "memory");
}
__device__ __forceinline__ int up_row(int n0) { return n0 < FF ? (n0 >> 7) * 256 + (n0 & 127) : ((n0 - FF) >> 7) * 256 + 128 + ((n0 - FF) & 127); }

__device__ __forceinline__ void convert_part(const AP& a, unsigned char* lds, int part, int worker, int nworkers, int lane, int wave) {
    float* scr = (float*)(lds + wave * 16384);
    unsigned char* ws = a.ws();
    constexpr int I_UP = (D / 64) * (2 * FF / 32), I_DN = (FF / 64) * (D / 32), I_IN = (D / 64) * 145, I_OUT = (D / 64) * (D / 32),
                  I_ADA = (D / 64) * (18432 / 32), I_ADAF = (D / 64) * (4096 / 32), I_G = 32;
    if (part == 0) {
        constexpr int NIT = I_ADA + I_ADAF + I_UP + 2 * I_G;
        for (int it = worker; it < NIT; it += nworkers) {
            int r = it;
            if (r < I_ADA) { const int kb = r / 576, nb = r % 576; p0_item(a.in(I_WADA), D, 18432, (bf16_t*)(ws + WS_ADA), kb * 64, nb * 32, nb * 32, scr, lane); continue; }
            r -= I_ADA;
            if (r < I_ADAF) { const int kb = r / 128, nb = r % 128; p0_item(a.in(I_WADAF), D, 4096, (bf16_t*)(ws + WS_ADA), kb * 64, nb * 32, 18432 + nb * 32, scr, lane); continue; }
            r -= I_ADAF;
            if (r < I_UP) { const int nblk = 2 * FF / 32, kb = r / nblk, nb = r % nblk; p0_item(a.in(I_WUP1), D, 2 * FF, (bf16_t*)(ws + WS_WUP1), kb * 64, nb * 32, up_row(nb * 32), scr, lane); continue; }
            r -= I_UP;
            { const int w = r >= I_G; r -= w * I_G; const int h = r >> 1, nb = r & 1;
              p0_item(a.in(w ? I_LWI : I_LWA) + h * 4096, 64, 64, (bf16_t*)(ws + (w ? WS_WIT : WS_WAT)) + h * 4096, 0, nb * 32, nb * 32, scr, lane); }
        }
    } else if (part == 1) {
        constexpr int NIT = I_DN + I_IN + I_OUT;
        for (int it = worker; it < NIT; it += nworkers) {
            int r = it;
            if (r < I_DN) { const int nblk = D / 32, kb = r / nblk, nb = r % nblk; p0_item(a.in(I_WDN1), FF, D, (bf16_t*)(ws + WS_WDN1), kb * 64, nb * 32, nb * 32, scr, lane); continue; }
            r -= I_DN;
            if (r < I_IN) { const int kb = r / 145, nb = r % 145; p0_item(a.in(I_WIN), D, INC, (bf16_t*)(ws + WS_WIN), kb * 64, nb * 32, nb * 32, scr, lane); continue; }
            r -= I_IN;
            { const int kb = r / 64, nb = r % 64; p0_item(a.in(I_WOUT), D, D, (bf16_t*)(ws + WS_WOUT), kb * 64, nb * 32, nb * 32, scr, lane, (kb * 64 + 1024) & 2047); }
        }
    } else {
        constexpr int NIT = I_UP + I_DN;
        for (int it = worker; it < NIT; it += nworkers) {
            int r = it;
            if (r < I_UP) { const int nblk = 2 * FF / 32, kb = r / nblk, nb = r % nblk; p0_item(a.in(I_WUP2), D, 2 * FF, (bf16_t*)(ws + WS_WUP2), kb * 64, nb * 32, up_row(nb * 32), scr, lane); continue; }
            r -= I_UP;
            { const int nblk = D / 32, kb = r / nblk, nb = r % nblk; p0_item(a.in(I_WDN2), FF, D, (bf16_t*)(ws + WS_WDN2), kb * 64, nb * 32, nb * 32, scr, lane); }
        }
    }
}
__device__ __forceinline__ void convert_in_tail(const AP& a, unsigned char* lds, int part, int nunits, int bx, int G, int lane, int wave) {
    const int lo = nunits % G;
    if (bx >= lo) convert_part(a, lds, part, (bx - lo) * 8 + wave, (G - lo) * 8, lane, wave);
}
__device__ __forceinline__ void phase0(const AP& a, unsigned char* lds, int gw, int NGW, int lane, int wave) {
    convert_part(a, lds, 0, gw, NGW, lane, wave);
    { unsigned* rsz = (unsigned*)(a.ws() + WS_RS); for (int i = gw * 64 + lane; i < 3 * 10240 + MP; i += NGW * 64) rsz[i] = 0u; }
    unsigned char* ws = a.ws();
    bf16_t* cact = (bf16_t*)(ws + WS_CACT);
    for (int e = gw * 64 + lane; e < (NB + NS) * D / 4; e += NGW * 64) {
        const int row = e / (D / 4), c4 = e % (D / 4);
        const float* src = row < NB ? a.in(I_CP) + (size_t)row * D : a.in(I_CS) + (size_t)(row - NB) * D;
        const f32x4 v = *(const f32x4*)(src + c4 * 4);
        u32x2 o; o.x = pk2(siluf(v.x), siluf(v.y)); o.y = pk2(siluf(v.z), siluf(v.w));
        *(u32x2*)(cact + (size_t)row * D + c4 * 4) = o;
    }
}

template <bool FINAL>
__device__ __forceinline__ void norm_phase(const float* xp, const float* xs, const float* part, int nsplit, float* xw, const float* g, const float* mod, int sh_off, int sc_off, bf16_t* H, float* outp, float* outs, int gw, int NGW, int lane, int row_begin = 0) {
    for (int row = row_begin + gw; row < MV; row += NGW) {
        const float* src = row < TP ? xp + (size_t)row * D : xs + (size_t)(row - TP) * D;
        const float* mr = mod + (size_t)batch_row(row) * NMOD;
        f32x4 v[8]; float ss = 0.f;
#pragma unroll
        for (int j = 0; j < 8; ++j) v[j] = *(const f32x4*)(src + (64 * j + lane) * 4);
        if (row >= TP && nsplit > 0) {
            const float* pp = part + (size_t)(row - TP) * D + lane * 4;
            int k = 0;
#pragma unroll 1
            for (; k + 4 <= nsplit; k += 4) { f32x4 t[4][8];
#pragma unroll
                for (int u = 0; u < 4; ++u)
#pragma unroll
                    for (int j = 0; j < 8; ++j) t[u][j] = *(const f32x4*)(pp + (size_t)(k + u) * 128 * D + 256 * j);
#pragma unroll
                for (int u = 0; u < 4; ++u)
#pragma unroll
                    for (int j = 0; j < 8; ++j) v[j] += t[u][j]; }
#pragma unroll 1
            for (; k < nsplit; ++k) {
#pragma unroll
                for (int j = 0; j < 8; ++j) v[j] += *(const f32x4*)(pp + (size_t)k * 128 * D + 256 * j); }
            if (xw) {
#pragma unroll
                for (int j = 0; j < 8; ++j) *(f32x4*)(xw + (size_t)row * D + (64 * j + lane) * 4) = v[j]; }
        }
#pragma unroll
        for (int j = 0; j < 8; ++j) ss += (v[j].x * v[j].x + v[j].y * v[j].y) + (v[j].z * v[j].z + v[j].w * v[j].w);
        const float rstd = rsqrtf(wave_sum(ss) * (1.f / D) + EPS);
#pragma unroll
        for (int j = 0; j < 8; ++j) { const int c = (64 * j + lane) * 4;
            const f32x4 gg = *(const f32x4*)(g + c), sc = *(const f32x4*)(mr + sc_off + c) + *(const f32x4*)(mr + MODB + sc_off + c), sh = *(const f32x4*)(mr + sh_off + c) + *(const f32x4*)(mr + MODB + sh_off + c);
            const f32x4 y = (v[j] * rstd * gg) * (sc + 1.f) + sh;
            if (FINAL) { float* o = row < TP ? outp + (size_t)row * D : outs + (size_t)(row - TP) * D; *(f32x4*)(o + c) = y; }
            else { u32x2 o; o.x = pk2(y.x, y.y); o.y = pk2(y.z, y.w); *(u32x2*)(H + (size_t)row * D + c) = o; } }
    }
}


__device__ __forceinline__ void norm1_prompt(const float* xp, const float* g, const float* mod, int sh_off, int sc_off, bf16_t* H, int gw, int NGW, int lane) {
#pragma unroll 1
    for (int r0 = gw * 4; r0 < TP; r0 += NGW * 4) {
        const float* mr = mod + (size_t)(r0 >> 11) * NMOD;
        f32x4 gs[8], sh[8];
#pragma unroll
        for (int j = 0; j < 8; ++j) { const int c = (64 * j + lane) * 4;
            gs[j] = *(const f32x4*)(g + c) * ((*(const f32x4*)(mr + sc_off + c) + *(const f32x4*)(mr + MODB + sc_off + c)) + 1.f);
            sh[j] = *(const f32x4*)(mr + sh_off + c) + *(const f32x4*)(mr + MODB + sh_off + c);
            if (j & 1) asm volatile("" ::: "memory"); }
        f32x4 va[2][8], vb[2][8];
#pragma unroll
        for (int r = 0; r < 2; ++r)
#pragma unroll
            for (int j = 0; j < 8; ++j) va[r][j] = *(const f32x4*)(xp + (size_t)(r0 + r) * D + (64 * j + lane) * 4);
#pragma unroll
        for (int r = 0; r < 2; ++r)
#pragma unroll
            for (int j = 0; j < 8; ++j) vb[r][j] = *(const f32x4*)(xp + (size_t)(r0 + 2 + r) * D + (64 * j + lane) * 4);
#define NORM1_ROWS(V, RB) do { _Pragma("unroll") for (int r = 0; r < 2; ++r) { float ss = 0.f; \
            _Pragma("unroll") for (int j = 0; j < 8; ++j) { const f32x4 v = V[r][j]; ss += (v.x * v.x + v.y * v.y) + (v.z * v.z + v.w * v.w); } \
            const float rstd = rsqrtf(wave_sum(ss) * (1.f / D) + EPS); \
            _Pragma("unroll") for (int j = 0; j < 8; ++j) { const f32x4 y = (V[r][j] * rstd) * gs[j] + sh[j]; \
                u32x2 o; o.x = pk2(y.x, y.y); o.y = pk2(y.z, y.w); *(u32x2*)(H + (size_t)(r0 + (RB) + r) * D + (64 * j + lane) * 4) = o; } } } while (0)
        NORM1_ROWS(va, 0);
        NORM1_ROWS(vb, 2);
#undef NORM1_ROWS
    }
}


__device__ __forceinline__ void final_sample_norm(const AP& a, unsigned char* lds, int rl, int lane, int wave) {
    unsigned char* ws = a.ws();
    const float* part = (const float*)(ws + WS_PART) + (size_t)rl * D + lane * 4;
    const float* xrow = (const float*)(ws + WS_X) + (size_t)(TP + rl) * D + lane * 4;
    constexpr int NSP = FF / KSPL;
    f32x4 v[8], t0[8], t1[8], t2[8];
#pragma unroll
    for (int j = 0; j < 8; ++j) { t0[j] = *(const f32x4*)(part + (size_t)wave * 128 * D + 256 * j);
        t1[j] = *(const f32x4*)(part + (size_t)(wave + 8) * 128 * D + 256 * j);
        t2[j] = (wave + 16 < NSP) ? *(const f32x4*)(part + (size_t)(wave + 16) * 128 * D + 256 * j) : (f32x4){0.f, 0.f, 0.f, 0.f};
        v[j] = (wave == 0) ? *(const f32x4*)(xrow + 256 * j) : (f32x4){0.f, 0.f, 0.f, 0.f}; }
    float* s_red = (float*)lds;
    float* s_ss = s_red + 8 * D;
#pragma unroll
    for (int j = 0; j < 8; ++j) *(f32x4*)(s_red + wave * D + 256 * j + lane * 4) = (v[j] + t0[j]) + (t1[j] + t2[j]);
    __syncthreads();
    const int c = wave * 256 + lane * 4;
    f32x4 x = *(const f32x4*)(s_red + c);
#pragma unroll
    for (int w = 1; w < 8; ++w) x += *(const f32x4*)(s_red + w * D + c);
    const float ss = wave_sum((x.x * x.x + x.y * x.y) + (x.z * x.z + x.w * x.w));
    if (lane == 0) s_ss[wave] = ss;
    const float* mr = (const float*)(ws + WS_MOD) + (size_t)(NB + rl) * NMOD;
    const f32x4 gg = *(const f32x4*)(a.in(I_GFIN) + c), sc = *(const f32x4*)(mr + 10 * D + c) + *(const f32x4*)(mr + MODB + 10 * D + c), sh = *(const f32x4*)(mr + 9 * D + c) + *(const f32x4*)(mr + MODB + 9 * D + c);
    __syncthreads();
    float tot = 0.f;
#pragma unroll
    for (int w = 0; w < 8; ++w) tot += s_ss[w];
    const float rstd = rsqrtf(tot * (1.f / D) + EPS);
    *(f32x4*)(a.out() + O_YS + (size_t)rl * D + c) = (x * rstd * gg) * (sc + 1.f) + sh;
}

constexpr int LD = 136;
__device__ __forceinline__ f32x4 mfma16(bf16x8 a, bf16x8 b, f32x4 c) { return __builtin_amdgcn_mfma_f32_16x16x32_bf16(a, b, c, 0, 0, 0); }

__device__ __forceinline__ void ssd_pass1(const AP& a, unsigned char* lds, int item, int tid, int lane, int wave) {
    const int hh = item & 1, g = (item >> 1) & 1, c = (item >> 2) & 15, b = item >> 6, h0 = g * 8 + hh * 4;
    const int row0 = b * SEQ + c * 128;
    unsigned char* ws = a.ws();
    const float* proj = (const float*)(ws + WS_BIG);
    bf16_t* sC = (bf16_t*)lds; bf16_t* sB = (bf16_t*)(lds + 34816); bf16_t* sBT = (bf16_t*)(lds + 69632);
    bf16_t* sXT = (bf16_t*)(lds + 34816); bf16_t* sXdT = (bf16_t*)(lds + 52224);
    float* s_cs = (float*)(lds + 104448); float* s_dt = s_cs + 512; float* s_da = s_dt + 512;
    const int l0 = wave * 16, fr = lane & 15, fq = lane >> 4;
    {
        const int hl = tid >> 7, l = tid & 127, h = h0 + hl;
        const float Ah = -expf(a.in(I_ALOG)[h]);
        const float dt = softplusf(proj[(size_t)(row0 + l) * INCP + PC_DT + h] + a.in(I_DTB)[h]); s_dt[tid] = dt; s_da[tid] = dt * Ah;
    }
    {
        const float* cw = a.in(I_SCW); const float* cb = a.in(I_SCB); bf16_t* cact2 = (bf16_t*)(ws + WS_CACT2);
#pragma unroll
        for (int cg4 = 0; cg4 < 4; ++cg4) {
            const int n = (cg4 & 1) * 64 + lane;
            const int xcol = (cg4 < 2 ? 1024 : 1280) + g * 128 + n;
            const float w0 = cw[xcol], w1 = cw[CONVD + xcol], w2 = cw[2 * CONVD + xcol], w3 = cw[3 * CONVD + xcol], bb = cb[xcol];
            const float* pcol = proj + PC_XBC + xcol;
            float pv[19];
#pragma unroll
            for (int i = 0; i < 19; ++i) { const int l = l0 - 3 + i; pv[i] = (c * 128 + l >= 0) ? pcol[(size_t)(row0 + l) * INCP] : 0.f; }
            unsigned pkv[8];
#pragma unroll
            for (int i = 0; i < 16; i += 2) {
                const float v0 = siluf(bb + w0 * pv[i] + w1 * pv[i + 1] + w2 * pv[i + 2] + w3 * pv[i + 3]), v1 = siluf(bb + w0 * pv[i + 1] + w1 * pv[i + 2] + w2 * pv[i + 3] + w3 * pv[i + 4]);
                pkv[i >> 1] = pk2(v0, v1);
            }
#pragma unroll
            for (int i = 0; i < 16; ++i) {
                const int l = l0 + i; const bf16_t v = (bf16_t)((i & 1) ? (pkv[i >> 1] >> 16) : pkv[i >> 1]);
                if (cg4 < 2) sB[l * LD + n] = v;
                else { sC[l * LD + n] = v; if (hh == 0) cact2[(size_t)(row0 + l) * 256 + g * 128 + n] = v; }
            }
            if (cg4 < 2) { *(u32x4*)(sBT + n * LD + l0) = (u32x4){pkv[0], pkv[1], pkv[2], pkv[3]}; *(u32x4*)(sBT + n * LD + l0 + 8) = (u32x4){pkv[4], pkv[5], pkv[6], pkv[7]}; }
        }
    }
    __syncthreads();
    {
        const int hl = tid >> 7, l = tid & 127; float v = s_da[tid];
#pragma unroll
        for (int o = 1; o < 64; o <<= 1) { const float t = __shfl_up(v, o); v += (lane >= o) ? t : 0.f; }
        if (l >= 64) v += wave_sum(s_da[hl * 128 + lane]);
        s_cs[tid] = v; ((float*)(ws + WS_CS))[(size_t)(row0 + l) * 16 + h0 + hl] = v;
        if (l == 127) ((float*)(ws + WS_CD))[(b * NCH + c) * 16 + h0 + hl] = __expf(v);
    }
    const int stmax = wave | 1, kmax = (wave * 16 + 15) >> 5;
    f32x4 cbv[8];
    {
        bf16x8 af[4];
#pragma unroll
        for (int kk = 0; kk < 4; ++kk) af[kk] = *(const bf16x8*)(sC + (l0 + fr) * LD + kk * 32 + fq * 8);
#pragma unroll
        for (int st = 0; st < 8; ++st) {
            cbv[st] = (f32x4){0.f, 0.f, 0.f, 0.f};
            if (st <= stmax) {
#pragma unroll
                for (int kk = 0; kk < 4; ++kk) { const bf16x8 bfv = *(const bf16x8*)(sB + (st * 16 + fr) * LD + kk * 32 + fq * 8); cbv[st] = mfma16(af[kk], bfv, cbv[st]); }
            }
        }
    }
    __syncthreads();
    bf16_t* sM = sC;
    bf16_t* xs_g = (bf16_t*)(ws + WS_XS); float* ypart = (float*)(ws + WS_YPART);
    const float* cw = a.in(I_SCW); const float* cb = a.in(I_SCB);
    float pvn[19];
#define SSD_LOADX(hl_) do { const float* pc_ = proj + (size_t)(row0 + l0 - 3) * INCP + PC_XBC + (h0 + (hl_)) * 64 + lane; \
        _Pragma("unroll") for (int i = 0; i < 19; ++i) pvn[i] = (c * 128 + l0 - 3 + i >= 0) ? pc_[(size_t)i * INCP] : 0.f; } while (0)
    SSD_LOADX(0);
#pragma unroll 1
    for (int hl = 0; hl < 4; ++hl) {
        const int h = h0 + hl;
        const float* cs = s_cs + hl * 128; const float* dts = s_dt + hl * 128;
        const float cs_last = cs[127];
        {
            const int xcol = h * 64 + lane;
            const float w0 = cw[xcol], w1 = cw[CONVD + xcol], w2 = cw[2 * CONVD + xcol], w3 = cw[3 * CONVD + xcol], bb = cb[xcol];
            float pv[19];
#pragma unroll
            for (int i = 0; i < 19; ++i) pv[i] = pvn[i];
            if (hl < 3) SSD_LOADX(hl + 1);
            unsigned pkx[8], pkd[8];
#pragma unroll
            for (int i = 0; i < 16; i += 2) {
                const int l = l0 + i;
                const float v0 = siluf(bb + w0 * pv[i] + w1 * pv[i + 1] + w2 * pv[i + 2] + w3 * pv[i + 3]), v1 = siluf(bb + w0 * pv[i + 1] + w1 * pv[i + 2] + w2 * pv[i + 3] + w3 * pv[i + 4]);
                const float x0 = v0 * dts[l], x1 = v1 * dts[l + 1];
                pkx[i >> 1] = pk2(x0, x1); pkd[i >> 1] = pk2(x0 * __expf(cs_last - cs[l]), x1 * __expf(cs_last - cs[l + 1]));
                const unsigned pv2 = pk2(v0, v1);
                xs_g[(size_t)(row0 + l) * 1024 + xcol] = (bf16_t)pv2; xs_g[(size_t)(row0 + l + 1) * 1024 + xcol] = (bf16_t)(pv2 >> 16);
            }
            *(u32x4*)(sXT + lane * LD + l0) = (u32x4){pkx[0], pkx[1], pkx[2], pkx[3]}; *(u32x4*)(sXT + lane * LD + l0 + 8) = (u32x4){pkx[4], pkx[5], pkx[6], pkx[7]};
            *(u32x4*)(sXdT + lane * LD + l0) = (u32x4){pkd[0], pkd[1], pkd[2], pkd[3]}; *(u32x4*)(sXdT + lane * LD + l0 + 8) = (u32x4){pkd[4], pkd[5], pkd[6], pkd[7]};
        }
#pragma unroll
        for (int st = 0; st < 8; ++st) {
            if (st <= stmax) {
                const int sidx = st * 16 + fr; const float css = cs[sidx];
#pragma unroll
                for (int i = 0; i < 4; ++i) { const int l = l0 + fq * 4 + i;
                    const float mv = (sidx <= l) ? cbv[st][i] * __expf(cs[l] - css) : 0.f;
                    sM[l * LD + sidx] = (bf16_t)f2bf(mv); }
            }
        }
        __syncthreads();
#pragma unroll
        for (int pt = 0; pt < 4; ++pt) {
            f32x4 y = (f32x4){0.f, 0.f, 0.f, 0.f};
#pragma unroll
            for (int kk = 0; kk < 4; ++kk) if (kk <= kmax) {
                const bf16x8 am = *(const bf16x8*)(sM + (l0 + fr) * LD + kk * 32 + fq * 8);
                const bf16x8 bx = *(const bf16x8*)(sXT + (pt * 16 + fr) * LD + kk * 32 + fq * 8);
                y = mfma16(am, bx, y); }
#pragma unroll
            for (int i = 0; i < 4; ++i) ypart[(size_t)(row0 + l0 + fq * 4 + i) * 1024 + h * 64 + pt * 16 + fr] = y[i];
        }
        float* st_g = (float*)(ws + WS_ST) + (size_t)((b * NCH + c) * NH + h) * (HP * NST);
#pragma unroll
        for (int pt = 0; pt < 4; ++pt) {
            f32x4 sacc = (f32x4){0.f, 0.f, 0.f, 0.f};
#pragma unroll
            for (int kk = 0; kk < 4; ++kk) {
                const bf16x8 ax = *(const bf16x8*)(sXdT + (pt * 16 + fr) * LD + kk * 32 + fq * 8);
                const bf16x8 bb2 = *(const bf16x8*)(sBT + (wave * 16 + fr) * LD + kk * 32 + fq * 8);
                sacc = mfma16(ax, bb2, sacc); }
#pragma unroll
            for (int i = 0; i < 4; ++i) st_g[(pt * 16 + fq * 4 + i) * NST + wave * 16 + fr] = sacc[i];
        }
        __syncthreads();
    }
}

__device__ __forceinline__ void lru_pass1_all(const AP& a, unsigned char* lds, int bx, int G, int lane, int wave) {
    constexpr int NIT = NB * NCH * NH;
    if (bx >= NIT) return;
    unsigned char* ws = a.ws();
    const float* proj = (const float*)(ws + WS_BIG);
    float* s_xc = (float*)lds;
    bf16_t* s_xb = (bf16_t*)(lds + 33280);
    float* s_a = (float*)(lds + 51712);
    float* s_b = (float*)(lds + 84992);
    float* s_ag = (float*)(lds + 118272);
    bf16_t* acum = (bf16_t*)(ws + WS_ACUM); bf16_t* hloc = (bf16_t*)(ws + WS_HLOC);
    const int l0 = wave * 16, fr = lane & 15, fq = lane >> 4;
    int hcur = -1, par = 0;
    float w0 = 0.f, w1 = 0.f, w2 = 0.f, w3 = 0.f, bb = 0.f;
    float bav[4], biv[4], sp[4]; bf16x8 ba[4][2], bi[4][2];
    float pvn[19];
#define LRU_LOADPV(it_) do { const int h_ = (it_) & 15, c_ = ((it_) >> 4) & 15, b_ = (it_) >> 8; const float* pc_ = proj + (size_t)(b_ * SEQ + c_ * 128 + l0 - 3) * INCP + PC_XL + h_ * 64 + lane; \
        _Pragma("unroll") for (int i = 0; i < 19; ++i) pvn[i] = (c_ * 128 + l0 - 3 + i >= 0) ? pc_[(size_t)i * INCP] : 0.f; } while (0)
    LRU_LOADPV(bx);
#pragma unroll 1
    for (int it = bx; it < NIT; it += G) {
        const int h = it & 15, c = (it >> 4) & 15, b = it >> 8, row0 = b * SEQ + c * 128, ch = h * 64 + lane;
        if (h != hcur) {
            hcur = h;
            const float* cw = a.in(I_LCW); w0 = cw[ch]; w1 = cw[WL + ch]; w2 = cw[2 * WL + ch]; w3 = cw[3 * WL + ch]; bb = a.in(I_LCB)[ch];
            const bf16_t* waT = (const bf16_t*)(ws + WS_WAT) + h * 4096; const bf16_t* wiT = (const bf16_t*)(ws + WS_WIT) + h * 4096;
#pragma unroll
            for (int jt = 0; jt < 4; ++jt) { const int cj = h * 64 + jt * 16 + fr; bav[jt] = a.in(I_LBA)[cj]; biv[jt] = a.in(I_LBI)[cj]; sp[jt] = softplusf(-a.in(I_LLAM)[cj]);
#pragma unroll
                for (int kk = 0; kk < 2; ++kk) { ba[jt][kk] = *(const bf16x8*)(waT + (jt * 16 + fr) * 64 + kk * 32 + fq * 8); bi[jt][kk] = *(const bf16x8*)(wiT + (jt * 16 + fr) * 64 + kk * 32 + fq * 8); } }
        }
        float pv[19];
#pragma unroll
        for (int i = 0; i < 19; ++i) pv[i] = pvn[i];
        if (it + G < NIT) LRU_LOADPV(it + G);
#pragma unroll
        for (int i = 0; i < 16; ++i) { const int l = l0 + i;
            const float v = bb + w0 * pv[i] + w1 * pv[i + 1] + w2 * pv[i + 2] + w3 * pv[i + 3];
            s_xc[l * 65 + lane] = v; s_xb[l * 72 + lane] = (bf16_t)f2bf(v); }
        asm volatile("s_waitcnt lgkmcnt(0)" ::: "memory");
        {
            bf16x8 af[2];
#pragma unroll
            for (int kk = 0; kk < 2; ++kk) af[kk] = *(const bf16x8*)(s_xb + (l0 + fr) * 72 + kk * 32 + fq * 8);
#pragma unroll
            for (int jt = 0; jt < 4; ++jt) {
                f32x4 ra = (f32x4){0.f, 0.f, 0.f, 0.f}, ri = ra;
#pragma unroll
                for (int kk = 0; kk < 2; ++kk) { ra = mfma16(af[kk], ba[jt][kk], ra); ri = mfma16(af[kk], bi[jt][kk], ri); }
                const int j = jt * 16 + fr;
#pragma unroll
                for (int i = 0; i < 4; ++i) { const int l = l0 + fq * 4 + i;
                    const float r = sigm(ra[i] + bav[jt]), ig = sigm(ri[i] + biv[jt]);
                    const float la = -8.0f * r * sp[jt]; const float av = __expf(la);
                    const float bt = __builtin_sqrtf(1.f - av * av) * (ig * s_xc[l * 65 + j]);
                    s_a[l * 65 + j] = av; s_b[l * 65 + j] = bt; }
            }
        }
        asm volatile("s_waitcnt lgkmcnt(0)" ::: "memory");
        float sa[16], sb[16];
#pragma unroll
        for (int i = 0; i < 16; ++i) { sa[i] = s_a[(l0 + i) * 65 + lane]; sb[i] = s_b[(l0 + i) * 65 + lane]; }
        float A = 1.f, Bv = 0.f;
#pragma unroll
        for (int i = 0; i < 16; ++i) { A *= sa[i]; Bv = sa[i] * Bv + sb[i]; sa[i] = A; sb[i] = Bv; }
        float* ag = s_ag + par * 1024;
        ag[(wave * 64 + lane) * 2] = A; ag[(wave * 64 + lane) * 2 + 1] = Bv;
        __syncthreads();
        float Ain = 1.f, Bin = 0.f;
        for (int sg = 0; sg < wave; ++sg) { const float As = ag[(sg * 64 + lane) * 2], Bs = ag[(sg * 64 + lane) * 2 + 1]; Bin = As * Bin + Bs; Ain *= As; }
        float ac = 0.f, hl = 0.f;
#pragma unroll
        for (int i = 0; i < 16; ++i) { ac = Ain * sa[i]; hl = sa[i] * Bin + sb[i];
            acum[(size_t)(row0 + l0 + i) * 1024 + ch] = (bf16_t)f2bf(ac); hloc[(size_t)(row0 + l0 + i) * 1024 + ch] = (bf16_t)f2bf(hl); }
        if (wave == 7) { ((float*)(ws + WS_AGA))[(b * NCH + c) * 1024 + ch] = ac; ((float*)(ws + WS_AGB))[(b * NCH + c) * 1024 + ch] = hl; }
        par ^= 1;
    }
    __syncthreads();
#undef LRU_LOADPV
}

__device__ __forceinline__ void ssd_sample(const AP& a, unsigned char* lds, int item, int lane, int wave) {
    const int h = item & 15, b = item >> 4, g = h >> 3;
    unsigned char* ws = a.ws();
    const float* prow = (const float*)(ws + WS_BIG) + (size_t)(TP + b) * INCP;
    float* s_v = (float*)(lds + wave * 16384);
    f32x4 hvs[2][16];
    { const float* h0e = a.in(I_SSM) + (size_t)(b * NH + h) * (HP * NST) + (lane >> 5) * NST + (lane & 31) * 4;
#pragma unroll
      for (int i = 0; i < 32; ++i) hvs[i >> 4][i & 15] = __builtin_nontemporal_load((const f32x4*)(h0e + (size_t)i * 2 * NST)); }
    {
        const float* cw = a.in(I_SCW); const float* cb = a.in(I_SCB); const float* stc = a.in(I_SSC) + (size_t)b * 3 * CONVD;
#pragma unroll
        for (int q = 0; q < 5; ++q) {
            const int lc = q * 64 + lane;
            const int xcol = q == 0 ? h * 64 + lc : (q < 3 ? 1024 + g * 128 + (lc - 64) : 1280 + g * 128 + (lc - 192));
            const float v = cb[xcol] + cw[xcol] * stc[xcol] + cw[CONVD + xcol] * stc[CONVD + xcol] + cw[2 * CONVD + xcol] * stc[2 * CONVD + xcol] + cw[3 * CONVD + xcol] * prow[PC_XBC + xcol];
            s_v[lc] = siluf(v);
        }
        s_v[320 + lane] = bf2f(((const bf16_t*)(ws + WS_ZB))[(size_t)(TP + b) * 1024 + h * 64 + lane]);
    }
    const float dt = softplusf(prow[PC_DT + h] + a.in(I_DTB)[h]);
    const float dA = expf(dt * -expf(a.in(I_ALOG)[h])), Dh = a.in(I_SD)[h];
    asm volatile("s_waitcnt lgkmcnt(0)" ::: "memory");
    const int n4 = (lane & 31) * 4, ph = lane >> 5;
    f32x4 Bv, Cv;
#pragma unroll
    for (int j = 0; j < 4; ++j) { Bv[j] = s_v[64 + n4 + j]; Cv[j] = s_v[192 + n4 + j]; }
    const float* h0 = a.in(I_SSM) + (size_t)(b * NH + h) * (HP * NST) + ph * NST + n4;
    float* ho = a.out() + O_SSMS + (size_t)(b * NH + h) * (HP * NST) + ph * NST + n4;
    bf16_t* a2row = (bf16_t*)(ws + WS_H) + (size_t)(TP + b) * D + h * 64; const float* gnh = a.in(I_SNG) + h * 64;
    float ssq = 0.f;
#pragma unroll
    for (int half = 0; half < 2; ++half) {
#pragma unroll
        for (int i = 0; i < 16; ++i) {
            const int p = (half * 16 + i) * 2 + ph;
            const float xv = s_v[p], xdt = xv * dt;
            const f32x4 hn = hvs[half][i] * dA + Bv * xdt;
            __builtin_nontemporal_store(hn, (f32x4*)(ho + (size_t)(half * 16 + i) * 2 * NST));
            float yp = (hn.x * Cv.x + hn.y * Cv.y) + (hn.z * Cv.z + hn.w * Cv.w);
            yp += __shfl_xor(yp, 1); yp += __shfl_xor(yp, 2); yp += __shfl_xor(yp, 4); yp += __shfl_xor(yp, 8); yp += __shfl_xor(yp, 16);
            if ((lane & 31) == 0) { const float yg = (yp + Dh * xv) * siluf(s_v[320 + p]); a2row[p] = (bf16_t)f2bf(yg * gnh[p]); ssq += yg * yg; }
        }
    }
    ssq += __shfl_xor(ssq, 32);
    if (lane == 0) __hip_atomic_fetch_add((float*)(ws + WS_RSSQ) + TP + b, ssq, __ATOMIC_RELAXED, __HIP_MEMORY_SCOPE_AGENT);
    asm volatile("s_waitcnt lgkmcnt(0)" ::: "memory");
}

__device__ __forceinline__ void lru_sample(const AP& a, unsigned char* lds, int item, int tid, int lane, int wave) {
    const int P = item * 8 + wave, b = P >> 4, h = P & 15, j = lane, ch = h * 64 + j;
    unsigned char* ws = a.ws();
    const float* prow = (const float*)(ws + WS_BIG) + (size_t)(TP + b) * INCP;
    float* s_x = (float*)lds;
    const float* cw = a.in(I_LCW); const float* stc = a.in(I_SLC) + (size_t)b * 3 * WL;
    const float xc = a.in(I_LCB)[ch] + cw[ch] * stc[ch] + cw[WL + ch] * stc[WL + ch] + cw[2 * WL + ch] * stc[2 * WL + ch] + cw[3 * WL + ch] * prow[PC_XL + ch];
    s_x[tid] = xc;
    __syncthreads();
    const float* wa = a.in(I_LWA) + h * 4096 + j; const float* wi = a.in(I_LWI) + h * 4096 + j;
    float ra = a.in(I_LBA)[ch], ri = a.in(I_LBI)[ch];
#pragma unroll 32
    for (int i = 0; i < 64; ++i) { const float xv = s_x[wave * 64 + i]; ra += xv * wa[i * 64]; ri += xv * wi[i * 64]; }
    const float r = sigm(ra), ig = sigm(ri), sp = softplusf(-a.in(I_LLAM)[ch]);
    const float la = -8.0f * r * sp, av = expf(la), bt = sqrtf(-expm1f(2.f * la)) * (ig * xc);
    const float hn = av * a.in(I_SLH)[(size_t)b * WL + ch] + bt;
    a.out()[O_LHS + (size_t)b * WL + ch] = hn;
    ((bf16_t*)(ws + WS_H))[(size_t)(TP + b) * D + 1024 + ch] = (bf16_t)f2bf(hn * gelu_tanh(bf2f(((const bf16_t*)(ws + WS_GLB))[(size_t)(TP + b) * 1024 + ch])));
    __syncthreads();
}

__device__ __forceinline__ void conv_state_out(const AP& a, int gtid, int gthreads) {
    const float* proj = (const float*)(a.ws() + WS_BIG);
    for (int e = gtid; e < NB * 3 * WL; e += gthreads) { const int ch = e % WL, k = (e / WL) % 3, b = e / (3 * WL); a.out()[O_LCP + e] = proj[(size_t)(b * SEQ + SEQ - 3 + k) * INCP + PC_XL + ch]; }
    for (int e = gtid; e < NB * 3 * CONVD; e += gthreads) { const int ch = e % CONVD, k = (e / CONVD) % 3, b = e / (3 * CONVD); a.out()[O_SCP + e] = proj[(size_t)(b * SEQ + SEQ - 3 + k) * INCP + PC_XBC + ch]; }
    for (int e = gtid; e < NS * 3 * WL; e += gthreads) { const int ch = e % WL, k = (e / WL) % 3, b = e / (3 * WL);
        a.out()[O_LCS + e] = k < 2 ? a.in(I_SLC)[(size_t)(b * 3 + k + 1) * WL + ch] : proj[(size_t)(TP + b) * INCP + PC_XL + ch]; }
    for (int e = gtid; e < NS * 3 * CONVD; e += gthreads) { const int ch = e % CONVD, k = (e / CONVD) % 3, b = e / (3 * CONVD);
        a.out()[O_SCS + e] = k < 2 ? a.in(I_SSC)[(size_t)(b * 3 + k + 1) * CONVD + ch] : proj[(size_t)(TP + b) * INCP + PC_XBC + ch]; }
}

__device__ __forceinline__ void ssd_pass2(const AP& a, unsigned char* lds, int item, int tid, int lane, int wave) {
    const int h = item & 15, cq = (item >> 4) & 3, b = item >> 6, g = h >> 3;
    unsigned char* ws = a.ws();
    bf16_t* sC = (bf16_t*)lds; bf16_t* sH = (bf16_t*)(lds + 34816); float* s_cs = (float*)(lds + 52224);
    const float* stb = (const float*)(ws + WS_ST) + (size_t)(b * NCH * NH + h) * (HP * NST);
    const float* cd = (const float*)(ws + WS_CD) + b * NCH * 16 + h;
    f32x4 hv[4];
#pragma unroll
    for (int q = 0; q < 4; ++q) hv[q] = (f32x4){0.f, 0.f, 0.f, 0.f};
#pragma unroll 1
    for (int cp = 0; cp < 4 * cq; cp += 4) {
        f32x4 sv[4][4]; float dec[4];
#pragma unroll
        for (int u = 0; u < 4; ++u) { dec[u] = cd[(cp + u) * 16]; const float* sp = stb + (size_t)(cp + u) * (NH * HP * NST);
#pragma unroll
            for (int q = 0; q < 4; ++q) sv[u][q] = *(const f32x4*)(sp + (q * 512 + tid) * 4); }
#pragma unroll
        for (int u = 0; u < 4; ++u)
#pragma unroll
            for (int q = 0; q < 4; ++q) hv[q] = hv[q] * dec[u] + sv[u][q];
    }
    const int fr = lane & 15, fq = lane >> 4;
    float* ypart = (float*)(ws + WS_YPART); const bf16_t* xs_g = (const bf16_t*)(ws + WS_XS); const bf16_t* zb = (const bf16_t*)(ws + WS_ZB);
    const bf16_t* cact2 = (const bf16_t*)(ws + WS_CACT2);
    const float Dh = a.in(I_SD)[h];
    bf16_t* A2 = (bf16_t*)(ws + WS_H); float gnv[4];
#pragma unroll
    for (int pt = 0; pt < 4; ++pt) gnv[pt] = a.in(I_SNG)[h * 64 + pt * 16 + fr];
    u32x4 ct[4]; float csv = 0.f; f32x4 stv[4]; float dec = 0.f;
#define SSD2_LOADSTEP(c_) do { const int r0_ = b * SEQ + (c_) * 128; \
        _Pragma("unroll") for (int q = 0; q < 4; ++q) { const int e = q * 512 + tid, l = e >> 4, k8 = (e & 15) * 8; ct[q] = *(const u32x4*)(cact2 + (size_t)(r0_ + l) * 256 + g * 128 + k8); } \
        if (tid < 128) csv = ((const float*)(ws + WS_CS))[(size_t)(r0_ + tid) * 16 + h]; \
        dec = cd[(c_) * 16]; { const float* sp = stb + (size_t)(c_) * (NH * HP * NST); _Pragma("unroll") for (int q = 0; q < 4; ++q) stv[q] = *(const f32x4*)(sp + (q * 512 + tid) * 4); } } while (0)
    SSD2_LOADSTEP(cq * 4);
#pragma unroll 1
    for (int cc = 0; cc < 4; ++cc) {
        const int c = cq * 4 + cc, row0 = b * SEQ + c * 128;
#pragma unroll
        for (int q = 0; q < 4; ++q) { const int e = (q * 512 + tid) * 4, p = e >> 7, n = e & 127; u32x2 o; o.x = pk2(hv[q].x, hv[q].y); o.y = pk2(hv[q].z, hv[q].w); *(u32x2*)(sH + p * LD + n) = o; }
#pragma unroll
        for (int q = 0; q < 4; ++q) { const int e = q * 512 + tid, l = e >> 4, k8 = (e & 15) * 8; *(u32x4*)(sC + l * LD + k8) = ct[q]; }
        if (tid < 128) s_cs[tid] = csv;
        f32x4 stc[4]; const float decc = dec;
#pragma unroll
        for (int q = 0; q < 4; ++q) stc[q] = stv[q];
        float yp[4][4]; unsigned xz[4][4];
#pragma unroll
        for (int pt = 0; pt < 4; ++pt)
#pragma unroll
            for (int i = 0; i < 4; ++i) { const size_t row = (size_t)(row0 + wave * 16 + fq * 4 + i); const int col = h * 64 + pt * 16 + fr;
                yp[pt][i] = ypart[row * 1024 + col]; xz[pt][i] = (unsigned)xs_g[row * 1024 + col] | ((unsigned)zb[row * 1024 + col] << 16); }
        if (cc < 3) SSD2_LOADSTEP(c + 1);
        __syncthreads();
        bf16x8 af[4];
#pragma unroll
        for (int kk = 0; kk < 4; ++kk) af[kk] = *(const bf16x8*)(sC + (wave * 16 + fr) * LD + kk * 32 + fq * 8);
        float ssq[4] = {0.f, 0.f, 0.f, 0.f};
#pragma unroll
        for (int pt = 0; pt < 4; ++pt) {
            f32x4 y = (f32x4){0.f, 0.f, 0.f, 0.f};
#pragma unroll
            for (int kk = 0; kk < 4; ++kk) { const bf16x8 bh = *(const bf16x8*)(sH + (pt * 16 + fr) * LD + kk * 32 + fq * 8); y = mfma16(af[kk], bh, y); }
#pragma unroll
            for (int i = 0; i < 4; ++i) { const int l = wave * 16 + fq * 4 + i; const size_t row = (size_t)(row0 + l); const int col = h * 64 + pt * 16 + fr;
                const float yv = __expf(s_cs[l]) * y[i] + yp[pt][i] + Dh * bf2f(xz[pt][i] & 0xffffu);
                const float yg = yv * siluf(bf2f(xz[pt][i] >> 16));
                A2[row * D + col] = (bf16_t)f2bf(yg * gnv[pt]); ssq[i] += yg * yg; }
        }
#pragma unroll
        for (int i = 0; i < 4; ++i) { float sq = ssq[i]; sq += __shfl_xor(sq, 1); sq += __shfl_xor(sq, 2); sq += __shfl_xor(sq, 4); sq += __shfl_xor(sq, 8);
            if (fr == 0) __hip_atomic_fetch_add((float*)(ws + WS_RSSQ) + row0 + wave * 16 + fq * 4 + i, sq, __ATOMIC_RELAXED, __HIP_MEMORY_SCOPE_AGENT); }
#pragma unroll
        for (int q = 0; q < 4; ++q) hv[q] = hv[q] * decc + stc[q];
        if (c == NCH - 1) { float* o = a.out() + O_SSMP + (size_t)(b * NH + h) * (HP * NST);
#pragma unroll
            for (int q = 0; q < 4; ++q) *(f32x4*)(o + (q * 512 + tid) * 4) = hv[q]; }
        __syncthreads();
    }
#undef SSD2_LOADSTEP
}

__device__ __forceinline__ void lru_pass2(const AP& a, int item, int tid) {
    const int seg = item & 7, c = (item >> 3) & 15, b = item >> 7;
    unsigned char* ws = a.ws();
    const int ch = tid * 2;
    const float* aga = (const float*)(ws + WS_AGA) + (size_t)b * NCH * 1024 + ch; const float* agb = (const float*)(ws + WS_AGB) + (size_t)b * NCH * 1024 + ch;
    const bf16_t* acum = (const bf16_t*)(ws + WS_ACUM); const bf16_t* hloc = (const bf16_t*)(ws + WS_HLOC); const bf16_t* glb = (const bf16_t*)(ws + WS_GLB);
    bf16_t* A2 = (bf16_t*)(ws + WS_H);
    const int row0 = b * SEQ + c * 128 + seg * 16;
    f32x2 Av[15], Bv[15];
#pragma unroll
    for (int cp = 0; cp < 15; ++cp) { Av[cp] = *(const f32x2*)(aga + cp * 1024); Bv[cp] = *(const f32x2*)(agb + cp * 1024); }
    unsigned acp[16], hlp[16], glp[16];
#pragma unroll
    for (int i = 0; i < 16; ++i) { const size_t row = (size_t)(row0 + i);
        acp[i] = *(const unsigned*)(acum + row * 1024 + ch); hlp[i] = *(const unsigned*)(hloc + row * 1024 + ch); glp[i] = *(const unsigned*)(glb + row * 1024 + ch); }
    f32x2 Hin = (f32x2){0.f, 0.f};
#pragma unroll
    for (int cp = 0; cp < 15; ++cp) { const f32x2 hn = Av[cp] * Hin + Bv[cp]; Hin = cp < c ? hn : Hin; }
#pragma unroll
    for (int i = 0; i < 16; ++i) { const size_t row = (size_t)(row0 + i);
        const f32x2 ac = (f32x2){bf2f(acp[i] & 0xffffu), bf2f(acp[i] >> 16)}, hl = (f32x2){bf2f(hlp[i] & 0xffffu), bf2f(hlp[i] >> 16)}, gl = (f32x2){bf2f(glp[i] & 0xffffu), bf2f(glp[i] >> 16)};
        const f32x2 hv = ac * Hin + hl;
        *(unsigned*)(A2 + row * D + 1024 + ch) = pk2(hv.x * gelu_tanh(gl.x), hv.y * gelu_tanh(gl.y));
        if (c == NCH - 1 && seg == 7 && i == 15) *(f32x2*)(a.out() + O_LHP + (size_t)b * WL + ch) = hv; }
}

__device__ __forceinline__ void ssd_norm(const AP& a, int gw, int NGW, int lane) {
    unsigned char* ws = a.ws();
    const float* ssq = (const float*)(ws + WS_SSQ); bf16_t* A2 = (bf16_t*)(ws + WS_H);
    for (int row = gw; row < MV; row += NGW) {
        u32x4 v[2];
#pragma unroll
        for (int j = 0; j < 2; ++j) v[j] = *(const u32x4*)(A2 + (size_t)row * D + 1024 + (64 * j + lane) * 8);
        float s = lane < 16 ? ssq[(size_t)row * 16 + lane] : 0.f; s = wave_sum(s);
        const float rstd = rsqrtf(s * (1.f / 1024.f) + EPS);
#pragma unroll
        for (int j = 0; j < 2; ++j) { u32x4 o;
#pragma unroll
            for (int q = 0; q < 4; ++q) o[q] = pk2(bf2f(v[j][q] & 0xffffu) * rstd, bf2f(v[j][q] >> 16) * rstd);
            *(u32x4*)(A2 + (size_t)row * D + 1024 + (64 * j + lane) * 8) = o; }
    }
}

#define LAS __attribute__((address_space(3)))
#define XB_TMO      128
#define XB_XCNT(j)  (256  + 64 * (j))
#define XB_XSUB(j)  (1280 + 64 * (j))
#define XB_XGEN(j)  (2304 + 64 * (j))
#define XB_TOP      3328
#define XB_TOPGEN   3392
#define XCD_BAR_WORDS 3456
#define XB_SPIN_CAP (1u << 18)
__device__ __forceinline__ unsigned xb_ld(unsigned* p)              { return __hip_atomic_load(p, __ATOMIC_RELAXED, __HIP_MEMORY_SCOPE_AGENT); }
__device__ __forceinline__ unsigned xb_add(unsigned* p, unsigned v) { return __hip_atomic_fetch_add(p, v, __ATOMIC_RELAXED, __HIP_MEMORY_SCOPE_AGENT); }
__device__ __forceinline__ unsigned xb_xcc_id() { return (unsigned)__builtin_amdgcn_s_getreg((3 << 11) | 20) & 0xFu; }
#define XB_SPIN(cond, bar) do { unsigned _sp = 0; while (cond) { __builtin_amdgcn_s_sleep(1); \
    if ((++_sp & 255u) == 0u) { if (xb_ld(&(bar)[XB_TMO])) break; if (_sp > XB_SPIN_CAP) { atomicAdd(&(bar)[XB_TMO], 1u); break; } } } } while (0)
struct XcdBarrier { unsigned* bar; unsigned x; volatile LAS unsigned* st; };
__device__ __forceinline__ XcdBarrier xcd_barrier_post(unsigned* bar, volatile LAS unsigned* st) {
    XcdBarrier b; b.bar = bar; b.x = xb_xcc_id(); b.st = st;
    if (threadIdx.x == 0) (void)xb_add(&bar[XB_XCNT(b.x)], 1u);
    return b;
}
__device__ __forceinline__ void xcd_barrier_complete(unsigned* bar, unsigned x, unsigned& nloc, unsigned& nx) {
    const unsigned G = gridDim.x * gridDim.y * gridDim.z;
    unsigned sum, cnt, mine, sp = 0u;
    for (;;) {
        sum = 0u; cnt = 0u; mine = 0u;
#pragma unroll
        for (unsigned j = 0; j < 16; ++j) { const unsigned c = xb_ld(&bar[XB_XCNT(j)]); sum += c; cnt += (c > 0u) ? 1u : 0u; mine = (j == x) ? c : mine; }
        if (sum == G) break;
        __builtin_amdgcn_s_sleep(1);
        if ((++sp & 255u) == 0u) { if (xb_ld(&bar[XB_TMO])) break; if (sp > XB_SPIN_CAP) { atomicAdd(&bar[XB_TMO], 1u); break; } }
    }
    nloc = mine > 0u ? mine : 1u; nx = cnt > 0u ? cnt : 1u;
}
__device__ __forceinline__ void xcd_barrier(const XcdBarrier& b) {
    asm volatile("s_waitcnt vmcnt(0)" ::: "memory");
    __syncthreads();
    if (threadIdx.x == 0) {
        unsigned* bar = b.bar;
        __builtin_amdgcn_s_waitcnt(0);
        unsigned nloc = b.st[0], nx = b.st[1];
        if (nloc == 0u) { xcd_barrier_complete(bar, b.x, nloc, nx); b.st[0] = nloc; b.st[1] = nx; }
        const unsigned old = xb_add(&bar[XB_XSUB(b.x)], 1u);
        const unsigned gen = old / nloc;
        if (old + 1u == (gen + 1u) * nloc) {
            __builtin_amdgcn_fence(__ATOMIC_RELEASE, "agent");
            asm volatile("s_waitcnt vmcnt(0)" ::: "memory");
            const unsigned og = xb_add(&bar[XB_TOP], 1u);
            const unsigned tg = og / nx;
            if (og + 1u == (tg + 1u) * nx) xb_add(&bar[XB_TOPGEN], 1u);
            else XB_SPIN(xb_ld(&bar[XB_TOPGEN]) == tg, bar);
            __builtin_amdgcn_fence(__ATOMIC_ACQUIRE, "agent");
            xb_add(&bar[XB_XGEN(b.x)], 1u);
            asm volatile("s_waitcnt vmcnt(0)" ::: "memory");
        } else {
            XB_SPIN(xb_ld(&bar[XB_XGEN(b.x)]) == gen, bar);
            __builtin_amdgcn_fence(__ATOMIC_ACQUIRE, "agent");
            asm volatile("s_waitcnt vmcnt(0)" ::: "memory");
        }
    }
    __syncthreads();
}

constexpr int LDS_BYTES = 147456;
__global__ void __launch_bounds__(512, 2) hymba_fwd(Args kargs) {
    extern __shared__ __attribute__((aligned(16))) unsigned char lds[];
    cg::grid_group grid = cg::this_grid();
    const int G = gridDim.x, bx = blockIdx.x, NGW = G * 8;
#define TIDS() int tid = threadIdx.x; asm volatile("" : "+v"(tid)); const int lane = tid & 63, wave = __builtin_amdgcn_readfirstlane(tid >> 6), gw = bx * 8 + wave; (void)lane; (void)gw
    {   TIDS();
        const unsigned long long* ka = (const unsigned long long*)__builtin_amdgcn_kernarg_segment_ptr();
        if (tid < 37) ((unsigned long long*)(lds + ARGTAB_OFF))[tid] = ka[tid];
        __syncthreads();
    }
    AP a; a.tab = (const unsigned*)(lds + ARGTAB_OFF);
    volatile LAS unsigned* bst = (volatile LAS unsigned*)(lds + 131072 + 512);
    {   TIDS();
        if (tid == 0) { bst[0] = 0u; bst[1] = 0u; }
        if (kargs.never) grid.sync();
        (void)xcd_barrier_post((unsigned*)(a.ws() + WS_CTL), bst);
    }
#define GBAR() do { XcdBarrier xb_; xb_.bar = (unsigned*)(a.ws() + WS_CTL); xb_.x = xb_xcc_id(); xb_.st = bst; xcd_barrier(xb_); } while (0)
#define WSP(T, off) ((T*)(a.ws() + (off)))
    PG8_LAS unsigned char* ldsl = (PG8_LAS unsigned char*)lds;

    { TIDS(); phase0(a, lds, gw, NGW, lane, wave); }
    GBAR();
    { pg8::Gemm g{WSP(const bf16_t, WS_CACT), WSP(const bf16_t, WS_ADA), D, D, 1024}; ModSplitOrder S{G, bx};
      EpiMod E{WSP(float, WS_MOD), a.in(I_BADA), a.in(I_BADAF)}; pg8::gemm_phase(ldsl, g, S, E); }
    { TIDS(); unsigned* fl = WSP(unsigned, WS_CTL) + 3648;
      if (bx < 176 && (bx % 88) < 16) { asm volatile("s_waitcnt vmcnt(0)" ::: "memory"); __syncthreads();
          if (tid == 0) { __builtin_amdgcn_fence(__ATOMIC_RELEASE, "agent"); asm volatile("s_waitcnt vmcnt(0)" ::: "memory"); __hip_atomic_fetch_add(fl, 1u, __ATOMIC_RELAXED, __HIP_MEMORY_SCOPE_AGENT); } }
      if (tid == 0) { unsigned sp = 0; while (__hip_atomic_load(fl, __ATOMIC_RELAXED, __HIP_MEMORY_SCOPE_AGENT) < 32u) { __builtin_amdgcn_s_sleep(4); if (++sp > (1u << 22)) break; } }
      __syncthreads(); }
    { TIDS(); norm1_prompt(a.in(I_XP), a.in(I_GF1), WSP(const float, WS_MOD), 0 * D, 1 * D, WSP(bf16_t, WS_H), gw, NGW, lane);
      norm_phase<false>(a.in(I_XP), a.in(I_XS), nullptr, 0, nullptr, a.in(I_GF1), WSP(const float, WS_MOD), 0 * D, 1 * D, WSP(bf16_t, WS_H), nullptr, nullptr, gw, NGW, lane, TP); }
    GBAR();
    { pg8::Gemm g{WSP(const bf16_t, WS_H), WSP(const bf16_t, WS_WUP1), D, D, D}; pg8::StaticOrder S; S.init(MP / 256, 2 * FF / 256, G, bx); EpiSwiGLU E{WSP(bf16_t, WS_BIG)}; pg8::gemm_phase(ldsl, g, S, E); }
    { TIDS(); convert_in_tail(a, lds, 1, (MP / 256) * (2 * FF / 256), bx, G, lane, wave); }
    GBAR();
    { pg8::Gemm g{WSP(const bf16_t, WS_BIG), WSP(const bf16_t, WS_WDN1), FF, FF, FF}; pg8::StaticOrder S; S.init(TP / 256, D / 256, G, bx);
      EpiResNorm<false> E{a.in(I_XP), WSP(float, WS_X), WSP(const float, WS_MOD), 2 * D, 0.5f, a.in(I_GMIX), 3 * D, 4 * D, WSP(bf16_t, WS_H), nullptr, WSP(float, WS_RS), WSP(unsigned, WS_RS + 32768)}; pg8::gemm_phase(ldsl, g, S, E); }
    { pg8::Gemm g{WSP(const bf16_t, WS_BIG), WSP(const bf16_t, WS_WDN1), FF, FF, KSPL}; SampleSplitOrder S; S.init(FF / KSPL, KSPL, G, bx);
      EpiPart E{WSP(float, WS_PART), WSP(const float, WS_MOD) + 2 * D, 0.5f, KSPL}; pg8::gemm_phase(ldsl, g, S, E); }
    GBAR();
#define SAMPLE_NORM_THEN_FLAG(FLAGW, ...) do { if (bx >= 240) { TIDS(); norm_phase<false>(__VA_ARGS__, (bx - 240) * 8 + wave, 128, lane, TP); \
        asm volatile("s_waitcnt vmcnt(0)" ::: "memory"); __syncthreads(); \
        if (tid == 0) { __builtin_amdgcn_fence(__ATOMIC_RELEASE, "agent"); asm volatile("s_waitcnt vmcnt(0)" ::: "memory"); __hip_atomic_fetch_add(WSP(unsigned, WS_CTL) + (FLAGW), 1u, __ATOMIC_RELAXED, __HIP_MEMORY_SCOPE_AGENT); } } } while (0)
    SAMPLE_NORM_THEN_FLAG(3520, WSP(const float, WS_X), a.in(I_XS), WSP(const float, WS_PART), FF / KSPL, WSP(float, WS_X), a.in(I_GMIX), WSP(const float, WS_MOD), 3 * D, 4 * D, WSP(bf16_t, WS_H), nullptr, nullptr);
    { pg8::Gemm g{WSP(const bf16_t, WS_H), WSP(const bf16_t, WS_WIN), D, D, D}; pg8::StaticOrder S; S.init(MP / 256, INCP / 256, G, bx, WSP(unsigned, WS_CTL) + 3520, 16u);
      EpiProj E{WSP(float, WS_BIG), WSP(bf16_t, WS_GLB), WSP(bf16_t, WS_ZB)}; pg8::gemm_phase(ldsl, g, S, E); }
    { TIDS(); convert_in_tail(a, lds, 2, (MP / 256) * (INCP / 256), bx, G, lane, wave); }
    GBAR();
    { TIDS();
#define M1_SAMPLE_SSD() do { for (int it = gw; it < NS * NH; it += NGW) ssd_sample(a, lds, it, lane, wave); __syncthreads(); } while (0)
    const int slot = bx & 3;
    if (slot == 0) M1_SAMPLE_SSD();
    for (int it = bx; it < NB * NCH * 4; it += G) ssd_pass1(a, lds, it, tid, lane, wave);
    if (slot == 1) M1_SAMPLE_SSD();
    lru_pass1_all(a, lds, bx, G, lane, wave);
    if (slot == 2) M1_SAMPLE_SSD();
    for (int it = bx; it < NS * NH / 8; it += G) lru_sample(a, lds, it, tid, lane, wave);
    if (slot == 3) M1_SAMPLE_SSD();
    conv_state_out(a, bx * 512 + tid, G * 512); }
    GBAR();
    { TIDS();
    for (int it = bx; it < NB * 4 * NH; it += G) ssd_pass2(a, lds, it, tid, lane, wave);
    for (int it = bx; it < NB * NCH * 8; it += G) lru_pass2(a, it, tid); }
    GBAR();
    { pg8::Gemm g{WSP(const bf16_t, WS_H), WSP(const bf16_t, WS_WOUT), D, D, D}; pg8::StaticOrder S; S.init(TP / 256, D / 256, G, bx);
      float* X = WSP(float, WS_X); EpiResNorm<false, true> E{X, X, WSP(const float, WS_MOD), 5 * D, 1.0f, a.in(I_GF2), 6 * D, 7 * D, WSP(bf16_t, WS_H), nullptr, WSP(float, WS_RS + 40960), WSP(unsigned, WS_RS + 40960 + 32768)}; pg8::gemm_phase(ldsl, g, S, E); }
    { pg8::Gemm g{WSP(const bf16_t, WS_H), WSP(const bf16_t, WS_WOUT), D, D, KSPL}; SampleSplitOrder S; S.init(D / KSPL, KSPL, G, bx);
      EpiPart E{WSP(float, WS_PART), WSP(const float, WS_MOD) + 5 * D, 1.0f, KSPL, 1}; pg8::gemm_phase(ldsl, g, S, E); }
    GBAR();
    SAMPLE_NORM_THEN_FLAG(3584, WSP(const float, WS_X), WSP(const float, WS_X) + (size_t)TP * D, WSP(const float, WS_PART), D / KSPL, WSP(float, WS_X), a.in(I_GF2), WSP(const float, WS_MOD), 6 * D, 7 * D, WSP(bf16_t, WS_H), nullptr, nullptr);
    { pg8::Gemm g{WSP(const bf16_t, WS_H), WSP(const bf16_t, WS_WUP2), D, D, D}; pg8::StaticOrder S; S.init(MP / 256, 2 * FF / 256, G, bx, WSP(unsigned, WS_CTL) + 3584, 16u); EpiSwiGLU E{WSP(bf16_t, WS_BIG)}; pg8::gemm_phase(ldsl, g, S, E); }
    GBAR();
    { pg8::Gemm g{WSP(const bf16_t, WS_BIG), WSP(const bf16_t, WS_WDN2), FF, FF, FF}; pg8::StaticOrder S; S.init(TP / 256, D / 256, G, bx);
      float* X = WSP(float, WS_X); EpiResNorm<true> E{X, X, WSP(const float, WS_MOD), 8 * D, 0.5f, a.in(I_GFIN), 9 * D, 10 * D, nullptr, a.out() + O_YP, WSP(float, WS_RS + 81920), WSP(unsigned, WS_RS + 81920 + 32768)}; pg8::gemm_phase(ldsl, g, S, E); }
    { pg8::Gemm g{WSP(const bf16_t, WS_BIG), WSP(const bf16_t, WS_WDN2), FF, FF, KSPL}; SampleSplitOrder S; S.init(FF / KSPL, KSPL, G, bx);
      EpiPart E{WSP(float, WS_PART), WSP(const float, WS_MOD) + 8 * D, 0.5f, KSPL}; pg8::gemm_phase(ldsl, g, S, E); }
    GBAR();
    { TIDS(); static_assert(FF / KSPL > 8 && FF / KSPL <= 24, "final_sample_norm sums partials k, k+8, k+16"); if (bx < NS) final_sample_norm(a, lds, bx, lane, wave); }
}

extern "C" void kernel_launch(void* const* d_in, const int* in_sizes, int n_in, void* d_out, int out_size, void* d_ws, size_t ws_size, hipStream_t stream) {
    static int grid = 0;
    if (grid == 0) {
        if (n_in != 35 || (size_t)out_size != O_END || ws_size < WS_END) { fprintf(stderr, "kernel_launch: unexpected shapes: n_in %d out %d ws %zu (need %zu)\n", n_in, out_size, ws_size, (size_t)WS_END); grid = -1; return; }
        int dev = 0, cus = 0, per_cu = 0;
        hipGetDevice(&dev); hipDeviceGetAttribute(&cus, hipDeviceAttributeMultiprocessorCount, dev);
        hipFuncSetAttribute((const void*)hymba_fwd, hipFuncAttributeMaxDynamicSharedMemorySize, LDS_BYTES);
        hipOccupancyMaxActiveBlocksPerMultiprocessor(&per_cu, (const void*)hymba_fwd, 512, LDS_BYTES);
        if (per_cu < 1) { fprintf(stderr, "kernel_launch: occupancy query says %d blocks/CU\n", per_cu); grid = -1; return; }
        if (cus != 256) { fprintf(stderr, "kernel_launch: built for a 256-CU device (fused norm epilogues need one 256x256 unit per workgroup), got %d CUs\n", cus); grid = -1; return; }
        grid = cus;
    }
    if (grid < 0) return;
    if (hipMemsetAsync((char*)d_ws + WS_CTL, 0, 16384, stream) != hipSuccess) { fprintf(stderr, "kernel_launch: memset of barrier words failed\n"); return; }
    Args a{};
    for (int i = 0; i < 35; ++i) a.in[i] = (const float*)d_in[i];
    a.out = (float*)d_out; a.ws = (unsigned char*)d_ws;
    void* args[] = {&a};
    hipError_t e = hipLaunchCooperativeKernel((const void*)hymba_fwd, dim3(grid), dim3(512), args, LDS_BYTES, stream);
    if (e != hipSuccess) fprintf(stderr, "cooperative launch failed: %s (grid %d)\n", hipGetErrorString(e), grid);
}
```

```cpp
#include <hip/hip_runtime.h>
#include <hip/hip_cooperative_groups.h>
#include <cstdio>
#include <cstdint>
namespace cg = cooperative_groups;

namespace pg8 {
#define PG8_LAS __attribute__((address_space(3)))
typedef unsigned short bf16_t;
typedef short bf16x8 __attribute__((ext_vector_type(8)));
typedef float f32x4 __attribute__((ext_vector_type(4)));
typedef unsigned u32x4 __attribute__((ext_vector_type(4)));
constexpr int BM = 256, BK = 64, HALF = 128, HTB = HALF * BK * 2, STAGE_BYTES = 8 * HTB, NXCD = 8, WGM = 8;

__host__ __device__ __forceinline__ int lds_byte(int r, int c) { const int st = (r >> 4) * 2 + (c >> 5), rr = r & 15, cc = c & 31, ob = rr * 64 + cc * 2; return st * 1024 + (ob ^ (((ob >> 9) & 1) << 5)); }
__host__ __device__ __forceinline__ void stage_rc(int b, int& R, int& C) { const int st = b / 1024, sb = b % 1024, swz = sb ^ (((sb >> 9) & 1) << 5); R = (st >> 1) * 16 + swz / 64; C = (st & 1) * 32 + (swz % 64) / 2; }
__host__ __device__ __forceinline__ int perm32(int rho) { const int n = rho >> 4, i = rho & 15; return 8 * (i >> 2) + 4 * n + (i & 3); }

struct Unit { int pm, pn, ko; };
struct Gemm { const bf16_t* A; const bf16_t* Bt; int lda, ldb, K; };

struct StaticOrder {
    int nM, nN, nwg, G, c; unsigned* flag; unsigned want;
    __device__ void init(int nM_, int nN_, int G_, int c_, unsigned* flag_ = nullptr, unsigned want_ = 0) { nM = nM_; nN = nN_; nwg = nM * nN; G = G_; c = c_; flag = flag_; want = want_; }
    __device__ __forceinline__ void a_ready(const Unit& u) const {
        if (flag && u.pm == 32) { unsigned sp = 0; while ((unsigned)__builtin_amdgcn_readfirstlane(__hip_atomic_load(flag, __ATOMIC_RELAXED, __HIP_MEMORY_SCOPE_AGENT)) < want) { __builtin_amdgcn_s_sleep(4); if (++sp > (1u << 22)) break; } asm volatile("s_waitcnt vmcnt(0)" ::: "memory"); }
    }
    __device__ bool next(int i, Unit& u) const {
        const long L = (long)i * G + c; if (L >= nwg) return false;
        int wgid = (int)L; { const int q = nwg / NXCD, r = nwg % NXCD, xcd = wgid % NXCD, off = wgid / NXCD; wgid = (xcd < r ? xcd * (q + 1) : r * (q + 1) + (xcd - r) * q) + off; }
        const int nig = WGM * nN, gid = wgid / nig, fm = gid * WGM, gsz = (nM - fm) < WGM ? (nM - fm) : WGM;
        u.pm = fm + ((wgid % nig) % gsz); u.pn = (wgid % nig) / gsz; u.ko = 0; return true;
    }
};

__device__ __forceinline__ unsigned cvt_pk_bf16(float lo, float hi) { unsigned r; asm volatile("v_cvt_pk_bf16_f32 %0, %1, %2" : "=v"(r) : "v"(lo), "v"(hi)); return r; }

template <class Epi, class Sched>
__device__ __forceinline__ void gemm_phase(PG8_LAS unsigned char* lds, const Gemm g, const Sched& S, const Epi& E) {
    int tid = threadIdx.x; asm volatile("" : "+v"(tid));
    const int wid = __builtin_amdgcn_readfirstlane(tid >> 6), lane = tid & 63, wr = wid >> 2, wc = wid & 3, fr = lane & 15, fq = lane >> 4;
    const int nt = g.K / BK;
    unsigned voffA[2], voffB[2];
#pragma unroll
    for (int i = 0; i < 2; ++i) { int R, C; stage_rc(tid * 16 + i * 8192, R, C); const int Rb = Epi::PERM ? ((R & ~31) + perm32(R & 31)) : R;
        voffA[i] = (unsigned)(R * g.lda + C) * 2u; voffB[i] = (unsigned)(Rb * g.ldb + C) * 2u; }
    const size_t kstep = (size_t)(BK * 2);
    const size_t hstepA = (size_t)HALF * g.lda * 2, hstepB = (size_t)HALF * g.ldb * 2;
    const size_t tstepA = 2 * hstepA, tstepB = 2 * hstepB;
    const unsigned ldsw = (unsigned)wid * 1024u;
    const int aoff = lds_byte(wr * 64 + fr, fq * 8), boff = lds_byte(wc * 32 + fr, fq * 8);
#define PG8_SA(b, h) (((b) * 2 + (h)) * HTB)
#define PG8_SB(b, h) ((4 + (b) * 2 + (h)) * HTB)
#define PG8_STAGE(bufoff, gbase, voff) do { _Pragma("unroll") for (int _i = 0; _i < 2; ++_i) \
        __builtin_amdgcn_global_load_lds((const unsigned*)((const char*)(gbase) + (voff)[_i]), (PG8_LAS unsigned*)(lds + (bufoff) + ldsw + _i * 8192), 16, 0, 0); } while (0)
#define PG8_LDA(dst, b, h) do { _Pragma("unroll") for (int m = 0; m < 4; ++m) _Pragma("unroll") for (int k = 0; k < 2; ++k) dst[m][k] = *(const PG8_LAS bf16x8*)(lds + PG8_SA(b, h) + aoff + m * 2048 + k * 1024); } while (0)
#define PG8_LDB(dst, b, h) do { _Pragma("unroll") for (int n = 0; n < 2; ++n) _Pragma("unroll") for (int k = 0; k < 2; ++k) dst[n][k] = *(const PG8_LAS bf16x8*)(lds + PG8_SB(b, h) + boff + n * 2048 + k * 1024); } while (0)
#define PG8_MMA(ai, bj, At, Bt) do { __builtin_amdgcn_s_setprio(1); _Pragma("unroll") for (int m = 0; m < 4; ++m) _Pragma("unroll") for (int n = 0; n < 2; ++n) _Pragma("unroll") for (int k = 0; k < 2; ++k) \
        acc[ai][bj][m][n] = __builtin_amdgcn_mfma_f32_16x16x32_bf16(Bt[n][k], At[m][k], acc[ai][bj][m][n], 0, 0, 0); __builtin_amdgcn_s_setprio(0); } while (0)
#define PG8_WAIT_V(n) asm volatile("s_waitcnt vmcnt(" #n ")" ::: "memory")
#define PG8_WAIT_L(n) asm volatile("s_waitcnt lgkmcnt(" #n ")" ::: "memory")
#define PG8_BAR __builtin_amdgcn_s_barrier()
#define PG8_SCHED __builtin_amdgcn_sched_barrier(0)
    Unit cur, nxt; int ui = 0;
    if (!S.next(0, cur)) return;
    f32x4 acc[2][2][4][2];
#pragma unroll
    for (int a = 0; a < 2; ++a)
#pragma unroll
        for (int b = 0; b < 2; ++b)
#pragma unroll
            for (int m = 0; m < 4; ++m)
#pragma unroll
                for (int n = 0; n < 2; ++n) acc[a][b][m][n] = (f32x4){0.f, 0.f, 0.f, 0.f};
    bf16x8 At[4][2], B0[2][2], B1[2][2];
    const char* cA = (const char*)g.A + (size_t)cur.pm * tstepA + (size_t)cur.ko * 2; const char* cB = (const char*)g.Bt + (size_t)cur.pn * tstepB + (size_t)cur.ko * 2;
    S.a_ready(cur);
    PG8_STAGE(PG8_SB(0, 0), cB, voffB); PG8_STAGE(PG8_SB(0, 1), cB + hstepB, voffB); PG8_STAGE(PG8_SA(0, 0), cA, voffA); PG8_STAGE(PG8_SA(0, 1), cA + hstepA, voffA);
    if (wr == 1) PG8_BAR;
    PG8_WAIT_V(2); PG8_BAR;
    PG8_STAGE(PG8_SB(1, 0), cB + kstep, voffB); PG8_STAGE(PG8_SA(1, 0), cA + kstep, voffA); PG8_STAGE(PG8_SB(1, 1), cB + hstepB + kstep, voffB);
    PG8_WAIT_V(6); PG8_BAR;
    for (;;) {
        const bool has_next = S.next(ui + 1, nxt);
        const char* nA = has_next ? (const char*)g.A + (size_t)nxt.pm * tstepA + (size_t)nxt.ko * 2 : cA; const char* nB = has_next ? (const char*)g.Bt + (size_t)nxt.pn * tstepB + (size_t)nxt.ko * 2 : cB;
        for (int t = 0; t < nt; t += 2) {
            const bool last = (t == nt - 2);
            if constexpr (Epi::MIDSCALE) { if (t == 16) E.midscale(acc, cur, wr, fr); }
            const char* a1 = cA + (size_t)(t + 1) * kstep;
            const char* a2 = last ? nA : cA + (size_t)(t + 2) * kstep; const char* b2 = last ? nB : cB + (size_t)(t + 2) * kstep;
            const char* a3 = a2 + kstep; const char* b3 = b2 + kstep;
            if (last && has_next) S.a_ready(nxt);
            PG8_LDB(B0, 0, 0); PG8_LDB(B1, 0, 1); PG8_SCHED; PG8_LDA(At, 0, 0); PG8_STAGE(PG8_SA(1, 1), a1 + hstepA, voffA);
            PG8_WAIT_V(8); PG8_WAIT_L(0); PG8_BAR; PG8_MMA(0, 0, At, B0); PG8_MMA(0, 1, At, B1); PG8_BAR; PG8_SCHED;
            PG8_LDA(At, 0, 1); PG8_STAGE(PG8_SB(0, 0), b2, voffB); PG8_STAGE(PG8_SB(0, 1), b2 + hstepB, voffB); PG8_STAGE(PG8_SA(0, 0), a2, voffA);
            PG8_WAIT_V(8); PG8_WAIT_L(0); PG8_BAR; PG8_MMA(1, 0, At, B0); PG8_MMA(1, 1, At, B1); PG8_BAR; PG8_SCHED;
            PG8_LDB(B0, 1, 0); PG8_LDB(B1, 1, 1); PG8_SCHED; PG8_LDA(At, 1, 0); PG8_STAGE(PG8_SA(0, 1), a2 + hstepA, voffA);
            PG8_WAIT_V(8); PG8_WAIT_L(0); PG8_BAR; PG8_MMA(0, 0, At, B0); PG8_MMA(0, 1, At, B1); PG8_BAR; PG8_SCHED;
            PG8_LDA(At, 1, 1); PG8_STAGE(PG8_SB(1, 0), b3, voffB); PG8_STAGE(PG8_SB(1, 1), b3 + hstepB, voffB); PG8_STAGE(PG8_SA(1, 0), a3, voffA);
            PG8_WAIT_V(8); PG8_WAIT_L(0); PG8_BAR; PG8_MMA(1, 0, At, B0); PG8_MMA(1, 1, At, B1); PG8_BAR; PG8_SCHED;
        }
        if (wr == 0) PG8_BAR;
        E(acc, cur, wr, wc, fr, fq);
        if (!has_next) break;
#pragma unroll
        for (int a = 0; a < 2; ++a)
#pragma unroll
            for (int b = 0; b < 2; ++b)
#pragma unroll
                for (int m = 0; m < 4; ++m)
#pragma unroll
                    for (int n = 0; n < 2; ++n) acc[a][b][m][n] = (f32x4){0.f, 0.f, 0.f, 0.f};
        cur = nxt; cA = nA; cB = nB; ++ui;
        if (wr == 1) PG8_BAR;
    }
    PG8_WAIT_V(0);
    PG8_BAR;
#undef PG8_SA
#undef PG8_SB
#undef PG8_STAGE
#undef PG8_LDA
#undef PG8_LDB
#undef PG8_MMA
#undef PG8_WAIT_V
#undef PG8_WAIT_L
#undef PG8_BAR
#undef PG8_SCHED
}
}

using pg8::bf16_t; using pg8::bf16x8; using pg8::f32x4; using pg8::u32x4;
typedef float f32x2 __attribute__((ext_vector_type(2)));
typedef unsigned u32x2 __attribute__((ext_vector_type(2)));

constexpr int D = 2048, TP = 8192, SEQ = 2048, NB = 4, NS = 128, MV = TP + NS  , MP = 8448  ;
constexpr int FF = 5632, WL = 1024, WS_ = 1024, NH = 16, HP = 64, NST = 128, CONVD = 1536, INC = 4624, INCP = 4864;
constexpr int NMOD = 22528;
constexpr float EPS = 1e-6f;
constexpr int NCH = 16;
constexpr int PC_XL = 0, PC_GL = 1024, PC_Z = 2048, PC_XBC = 3072, PC_DT = 4608;
constexpr size_t O_YP = 0, O_YS = 16777216, O_LHP = 17039360, O_LCP = 17043456, O_SSMP = 17055744, O_SCP = 17580032,
                 O_LHS = 17598464, O_LCS = 17729536, O_SSMS = 18122752, O_SCS = 34899968, O_END = 35489792;
constexpr size_t SZ_WUP = (size_t)2 * FF * D * 2, SZ_WDN = (size_t)D * FF * 2;
constexpr size_t WS_WUP1 = 0, WS_WDN1 = WS_WUP1 + SZ_WUP, WS_WUP2 = WS_WDN1 + SZ_WDN, WS_WDN2 = WS_WUP2 + SZ_WUP;
constexpr size_t WS_WIN = WS_WDN2 + SZ_WDN, WS_WOUT = WS_WIN + (size_t)INCP * D * 2, WS_WAT = WS_WOUT + (size_t)D * D * 2, WS_WIT = WS_WAT + 131072;
constexpr size_t WS_CACT = WS_WIT + 131072, WS_MOD = WS_CACT + (size_t)256 * D * 2, WS_H = WS_MOD + (size_t)2 * 256 * NMOD * 4;
constexpr size_t MODB = (size_t)256 * NMOD;
constexpr size_t WS_X = WS_H + (size_t)MP * D * 2, WS_BIG = WS_X + (size_t)MP * D * 4, WS_ADA = WS_BIG + (size_t)MP * INCP * 4;
constexpr size_t WS_ST = WS_ADA + (size_t)NMOD * D * 2, WS_SMALL = WS_ST + (size_t)NB * NCH * NH * HP * NST * 4;
constexpr size_t WS_CS = WS_SMALL, WS_SSQ = WS_CS + (size_t)MP * 16 * 4, WS_AGA = WS_SSQ + (size_t)MP * 16 * 4, WS_AGB = WS_AGA + 262144, WS_CD = WS_AGB + 262144, WS_CTL = WS_CD + 4096, WS_PART = WS_CTL + 16384, WS_RS = WS_PART + (size_t)22 * 128 * D * 4, WS_RSSQ = WS_RS + 3 * 40960, WS_END = WS_RSSQ + (size_t)MP * 4;
constexpr int KSPL = 256;
constexpr size_t WS_YPART = WS_WUP1;
constexpr size_t WS_GLB = WS_ADA + (size_t)MP * 1024 * 2, WS_ZB = WS_ADA + (size_t)MP * 1024 * 6;
constexpr size_t WS_ACUM = WS_ADA, WS_HLOC = WS_ACUM + (size_t)MP * 1024 * 4, WS_XS = WS_HLOC + (size_t)MP * 1024 * 4, WS_CACT2 = WS_XS + (size_t)MP * 1024 * 2;
static_assert(WS_CACT2 + (size_t)MP * 256 * 2 <= WS_ST, "ada region overlay");
static_assert((size_t)MP * FF * 2 <= (size_t)MP * INCP * 4, "act fits in big");

__device__ __forceinline__ unsigned pk2(float lo, float hi) { unsigned r; asm("v_cvt_pk_bf16_f32 %0, %1, %2" : "=v"(r) : "v"(lo), "v"(hi)); return r; }
__device__ __forceinline__ unsigned f2bf(float f) { return pk2(f, 0.f); }
__device__ __forceinline__ float bf2f(unsigned h) { return __builtin_bit_cast(float, h << 16); }
__device__ __forceinline__ float sigm(float x) { return __builtin_amdgcn_rcpf(1.f + __expf(-x)); }
__device__ __forceinline__ float siluf(float x) { return x * __builtin_amdgcn_rcpf(1.f + __expf(-x)); }
__device__ __forceinline__ float softplusf(float x) { return x > 20.f ? x : log1pf(expf(x)); }
__device__ __forceinline__ float gelu_tanh(float x) { const float u = 0.7978845608028654f * (x + 0.044715f * x * x * x); return 0.5f * x * (1.f + tanhf(u)); }
__device__ __forceinline__ float wave_sum(float v) {
#pragma unroll
    for (int o = 1; o < 64; o <<= 1) v += __shfl_xor(v, o);
    return v;
}
__device__ __forceinline__ int batch_row(int row) { return row < TP ? (row >> 11) : (NB + row - TP); }

struct EpiSwiGLU {
    static constexpr bool MIDSCALE = false;
    static constexpr bool PERM = true;
    bf16_t* O;
    __device__ __forceinline__ void operator()(f32x4 (&acc)[2][2][4][2], const pg8::Unit& u, int wr, int wc, int fr, int fq) const {
        const int row0 = u.pm * 256 + wr * 64 + fr, col0 = u.pn * 128 + wc * 32 + 8 * fq;
#pragma unroll
        for (int ai = 0; ai < 2; ++ai)
#pragma unroll
            for (int m = 0; m < 4; ++m) {
                bf16_t* rowp = O + (size_t)(row0 + ai * 128 + m * 16) * FF + col0;
                float o[8];
#pragma unroll
                for (int n = 0; n < 2; ++n)
#pragma unroll
                    for (int j = 0; j < 4; ++j) { const float gv = acc[ai][0][m][n][j], uv = acc[ai][1][m][n][j]; o[n * 4 + j] = gv * __builtin_amdgcn_rcpf(1.f + __expf(-gv)) * uv; }
                u32x4 w; w.x = pg8::cvt_pk_bf16(o[0], o[1]); w.y = pg8::cvt_pk_bf16(o[2], o[3]); w.z = pg8::cvt_pk_bf16(o[4], o[5]); w.w = pg8::cvt_pk_bf16(o[6], o[7]);
                *(u32x4*)rowp = w;
            }
    }
};
struct EpiRes {
    static constexpr bool MIDSCALE = false;
    static constexpr bool PERM = false;
    const float* base_p; const float* base_s; float* out; const float* gate; float s;
    __device__ __forceinline__ void operator()(f32x4 (&acc)[2][2][4][2], const pg8::Unit& u, int wr, int wc, int fr, int fq) const {
        const int col0 = u.pn * 256 + wc * 32 + 4 * fq;
#pragma unroll
        for (int ai = 0; ai < 2; ++ai)
#pragma unroll
            for (int m = 0; m < 4; ++m) {
                const int row = u.pm * 256 + ai * 128 + wr * 64 + m * 16 + fr;
                if (row < MV) {
                    const float* bp = row < TP ? base_p + (size_t)row * D : base_s + (size_t)(row - TP) * D;
                    const float* gp = gate + (size_t)batch_row(row) * NMOD;
                    float* op = out + (size_t)row * D;
#pragma unroll
                    for (int bj = 0; bj < 2; ++bj)
#pragma unroll
                        for (int n = 0; n < 2; ++n) { const int c = col0 + bj * 128 + n * 16;
                            const f32x4 b = *(const f32x4*)(bp + c), gg = *(const f32x4*)(gp + c) + *(const f32x4*)(gp + MODB + c);
                            *(f32x4*)(op + c) = b + (gg * s) * acc[ai][bj][m][n]; }
                }
            }
    }
};
struct EpiProj {
    static constexpr bool PERM = false, MIDSCALE = false, MTRIM = false;
    float* out; bf16_t* glb; bf16_t* zb;
    __device__ __forceinline__ void operator()(f32x4 (&acc)[2][2][4][2], const pg8::Unit& u, int wr, int wc, int fr, int fq) const {
        const int colt = wc * 32 + 4 * fq;
        if (u.pn >= 4 && u.pn < 12) {
            bf16_t* ob = (u.pn < 8 ? glb : zb) + (u.pn & 3) * 256 + colt;
#pragma unroll
            for (int ai = 0; ai < 2; ++ai)
#pragma unroll
                for (int m = 0; m < 4; ++m) { const int row = u.pm * 256 + ai * 128 + wr * 64 + m * 16 + fr;
                    if (row < MV) { bf16_t* op = ob + (size_t)row * 1024;
#pragma unroll
                        for (int bj = 0; bj < 2; ++bj)
#pragma unroll
                            for (int n = 0; n < 2; ++n) { const f32x4 v = acc[ai][bj][m][n]; u32x2 o; o.x = pk2(v.x, v.y); o.y = pk2(v.z, v.w); *(u32x2*)(op + bj * 128 + n * 16) = o; } } }
        } else {
            const int col0 = u.pn * 256 + colt;
#pragma unroll
            for (int ai = 0; ai < 2; ++ai)
#pragma unroll
                for (int m = 0; m < 4; ++m) { const int row = u.pm * 256 + ai * 128 + wr * 64 + m * 16 + fr;
                    if (row < MV) { float* op = out + (size_t)row * INCP + col0;
#pragma unroll
                        for (int bj = 0; bj < 2; ++bj)
#pragma unroll
                            for (int n = 0; n < 2; ++n) *(f32x4*)(op + bj * 128 + n * 16) = acc[ai][bj][m][n]; } }
        }
    }
};
struct EpiF32 {
    static constexpr bool MIDSCALE = false;
    static constexpr bool PERM = false;
    float* out; int ldc; int mvalid; const float* bias1; const float* bias2; int split;
    __device__ __forceinline__ void operator()(f32x4 (&acc)[2][2][4][2], const pg8::Unit& u, int wr, int wc, int fr, int fq) const {
        const int col0 = u.pn * 256 + wc * 32 + 4 * fq;
        f32x4 bv[2][2];
#pragma unroll
        for (int bj = 0; bj < 2; ++bj)
#pragma unroll
            for (int n = 0; n < 2; ++n) { const int c = col0 + bj * 128 + n * 16;
                bv[bj][n] = bias1 ? (c < split ? *(const f32x4*)(bias1 + c) : *(const f32x4*)(bias2 + (c - split))) : (f32x4){0.f, 0.f, 0.f, 0.f}; }
#pragma unroll
        for (int ai = 0; ai < 2; ++ai)
#pragma unroll
            for (int m = 0; m < 4; ++m) {
                const int row = u.pm * 256 + ai * 128 + wr * 64 + m * 16 + fr;
                if (row < mvalid) {
                    float* op = out + (size_t)row * ldc;
#pragma unroll
                    for (int bj = 0; bj < 2; ++bj)
#pragma unroll
                        for (int n = 0; n < 2; ++n) *(f32x4*)(op + col0 + bj * 128 + n * 16) = acc[ai][bj][m][n] + bv[bj][n];
                }
            }
    }
};

template <bool FINAL, bool MID = false>
struct EpiResNorm {
    static constexpr bool PERM = false, MIDSCALE = MID;
    __device__ __forceinline__ void midscale(f32x4 (&acc)[2][2][4][2], const pg8::Unit& u, int wr, int fr) const {
        asm volatile("" : "+v"(fr));
#pragma unroll
        for (int ai = 0; ai < 2; ++ai)
#pragma unroll
            for (int m = 0; m < 4; ++m) { const float* rssq = rs + (WS_RSSQ - (WS_RS + 40960)) / 4;
                const float r = rsqrtf(rssq[u.pm * 256 + ai * 128 + wr * 64 + m * 16 + fr] * (1.f / 1024.f) + EPS);
#pragma unroll
                for (int bj = 0; bj < 2; ++bj)
#pragma unroll
                    for (int n = 0; n < 2; ++n) acc[ai][bj][m][n] = acc[ai][bj][m][n] * r; }
    }
    const float* base; float* X; const float* mod; int g_off; float s; const float* gw; int sh_off, sc_off; bf16_t* H; float* out; float* rs; unsigned* cnt;
    __device__ __forceinline__ void operator()(f32x4 (&acc)[2][2][4][2], const pg8::Unit& u, int wr, int wc, int fr, int fq) const {
        const int col0 = u.pn * 256 + wc * 32 + 4 * fq, row0 = u.pm * 256 + wr * 64 + fr;
        const float* mr = mod + (size_t)(row0 >> 11) * NMOD;
#pragma unroll
        for (int bj = 0; bj < 2; ++bj)
#pragma unroll
            for (int n = 0; n < 2; ++n) { const int c = col0 + bj * 128 + n * 16;
                const f32x4 gg = (*(const f32x4*)(mr + g_off + c) + *(const f32x4*)(mr + MODB + g_off + c)) * s;
#pragma unroll
                for (int ai = 0; ai < 2; ++ai)
#pragma unroll
                    for (int m = 0; m < 4; ++m) { const size_t off = (size_t)(row0 + ai * 128 + m * 16) * D + c; acc[ai][bj][m][n] = *(const f32x4*)(base + off) + gg * acc[ai][bj][m][n]; }
                asm volatile("" : "+v"(acc[0][bj][0][n]), "+v"(acc[0][bj][1][n]), "+v"(acc[0][bj][2][n]), "+v"(acc[0][bj][3][n]), "+v"(acc[1][bj][0][n]), "+v"(acc[1][bj][1][n]), "+v"(acc[1][bj][2][n]), "+v"(acc[1][bj][3][n]) :: "memory"); }
#pragma unroll
        for (int ai = 0; ai < 2; ++ai)
#pragma unroll
            for (int m = 0; m < 4; ++m) { float q = 0.f;
#pragma unroll
                for (int bj = 0; bj < 2; ++bj)
#pragma unroll
                    for (int n = 0; n < 2; ++n) { const f32x4 v = acc[ai][bj][m][n]; q += (v.x * v.x + v.y * v.y) + (v.z * v.z + v.w * v.w); }
                q += __shfl_xor(q, 16); q += __shfl_xor(q, 32);
                if (fq == 0) __hip_atomic_fetch_add(rs + row0 + ai * 128 + m * 16, q, __ATOMIC_RELAXED, __HIP_MEMORY_SCOPE_AGENT); }
        asm volatile("s_waitcnt vmcnt(0)" ::: "memory");
        unsigned* pc = cnt + 64 * u.pm;
        if ((threadIdx.x & 63) == 0) __hip_atomic_fetch_add(pc, 1u, __ATOMIC_RELAXED, __HIP_MEMORY_SCOPE_AGENT);
        { unsigned sp = 0; while ((unsigned)__builtin_amdgcn_readfirstlane(__hip_atomic_load(pc, __ATOMIC_RELAXED, __HIP_MEMORY_SCOPE_AGENT)) < 64u) { __builtin_amdgcn_s_sleep(2); if (++sp > (1u << 20)) break; } }
        asm volatile("s_waitcnt vmcnt(0)" ::: "memory");
        float rstd[2][4];
#pragma unroll
        for (int ai = 0; ai < 2; ++ai)
#pragma unroll
            for (int m = 0; m < 4; ++m) rstd[ai][m] = rsqrtf(__hip_atomic_load(rs + row0 + ai * 128 + m * 16, __ATOMIC_RELAXED, __HIP_MEMORY_SCOPE_AGENT) * (1.f / D) + EPS);
#pragma unroll
        for (int bj = 0; bj < 2; ++bj)
#pragma unroll
            for (int n = 0; n < 2; ++n) { const int c = col0 + bj * 128 + n * 16;
                const f32x4 gg = *(const f32x4*)(gw + c), sc1 = (*(const f32x4*)(mr + sc_off + c) + *(const f32x4*)(mr + MODB + sc_off + c)) + 1.f, sh = *(const f32x4*)(mr + sh_off + c) + *(const f32x4*)(mr + MODB + sh_off + c);
                const f32x4 gs = gg * sc1;
#pragma unroll
                for (int ai = 0; ai < 2; ++ai)
#pragma unroll
                    for (int m = 0; m < 4; ++m) { const size_t off = (size_t)(row0 + ai * 128 + m * 16) * D + c;
                        const f32x4 xv = acc[ai][bj][m][n];
                        const f32x4 y = (xv * rstd[ai][m]) * gs + sh;
                        if (FINAL) *(f32x4*)(out + off) = y;
                        else { *(f32x4*)(X + off) = xv; u32x2 o; o.x = pk2(y.x, y.y); o.y = pk2(y.z, y.w); *(u32x2*)(H + off) = o; } }
                asm volatile("" ::: "memory"); }
    }
};
struct ModSplitOrder {
    int G, c;
    __device__ __forceinline__ void a_ready(const pg8::Unit&) const {}
    __device__ bool next(int i, pg8::Unit& u) const { const int j = i * G + c; if (j >= 176) return false; u.pm = 0; u.pn = j % 88; u.ko = (j / 88) * 1024; return true; }
};
struct EpiMod {
    static constexpr bool MIDSCALE = false;
    static constexpr bool PERM = false;
    float* out; const float* bias1; const float* bias2;
    __device__ __forceinline__ void operator()(f32x4 (&acc)[2][2][4][2], const pg8::Unit& u, int wr, int wc, int fr, int fq) const {
        const int col0 = u.pn * 256 + wc * 32 + 4 * fq; float* ob = out + (u.ko ? MODB : 0);
        f32x4 bv[2][2];
#pragma unroll
        for (int bj = 0; bj < 2; ++bj)
#pragma unroll
            for (int n = 0; n < 2; ++n) { const int c = col0 + bj * 128 + n * 16;
                bv[bj][n] = u.ko == 0 ? (c < 18432 ? *(const f32x4*)(bias1 + c) : *(const f32x4*)(bias2 + (c - 18432))) : (f32x4){0.f, 0.f, 0.f, 0.f}; }
#pragma unroll
        for (int ai = 0; ai < 2; ++ai)
#pragma unroll
            for (int m = 0; m < 4; ++m) {
                const int row = ai * 128 + wr * 64 + m * 16 + fr;
                if (row < NB + NS) { float* op = ob + (size_t)row * NMOD;
#pragma unroll
                    for (int bj = 0; bj < 2; ++bj)
#pragma unroll
                        for (int n = 0; n < 2; ++n) *(f32x4*)(op + col0 + bj * 128 + n * 16) = acc[ai][bj][m][n] + bv[bj][n]; }
            }
    }
};
struct SampleSplitOrder {
    int n, G, c, KS;
    __device__ __forceinline__ void a_ready(const pg8::Unit&) const {}
    __device__ void init(int nsplit, int KS_, int G_, int c_) { n = 8 * nsplit; G = G_; c = c_; KS = KS_; }
    __device__ bool next(int i, pg8::Unit& u) const { const int j = i * G + c; if (j >= n) return false; u.pm = 32; u.pn = j & 7; u.ko = (j >> 3) * KS; return true; }
};
struct EpiPart {
    static constexpr bool MIDSCALE = false;
    static constexpr bool PERM = false;
    float* part; const float* gate; float s; int KS; int ssd_scale = 0;
    __device__ __forceinline__ void operator()(f32x4 (&acc)[2][2][4][2], const pg8::Unit& u, int wr, int wc, int fr, int fq) const {
        const int col0 = u.pn * 256 + wc * 32 + 4 * fq, ks = u.ko / KS;
#pragma unroll
        for (int m = 0; m < 4; ++m) {
            const int rl = wr * 64 + m * 16 + fr;
            const float* gp = gate + (size_t)(NB + rl) * NMOD; float* op = part + ((size_t)ks * 128 + rl) * D;
            const float sr = (ssd_scale && u.ko < 1024) ? s * rsqrtf((part + (WS_RSSQ - WS_PART) / 4)[TP + rl] * (1.f / 1024.f) + EPS) : s;
#pragma unroll
            for (int bj = 0; bj < 2; ++bj)
#pragma unroll
                for (int n = 0; n < 2; ++n) { const int c = col0 + bj * 128 + n * 16; const f32x4 gg = *(const f32x4*)(gp + c) + *(const f32x4*)(gp + MODB + c); *(f32x4*)(op + c) = (gg * sr) * acc[0][bj][m][n]; }
        }
    }
};

struct Args { const float* in[35]; float* out; unsigned char* ws; int never; int pad; };
constexpr int ARGTAB_OFF = 131072 + 1024;
struct AP {
    const unsigned* tab;
    __device__ __forceinline__ unsigned long long raw(int i) const { const unsigned lo = __builtin_amdgcn_readfirstlane(tab[2 * i]), hi = __builtin_amdgcn_readfirstlane(tab[2 * i + 1]); return ((unsigned long long)hi << 32) | lo; }
    __device__ __forceinline__ const float* in(int i) const { return (const float*)raw(i); }
    __device__ __forceinline__ float* out() const { return (float*)raw(35); }
    __device__ __forceinline__ unsigned char* ws() const { return (unsigned char*)raw(36); }
};
enum { I_XP = 0, I_XS, I_CP, I_CS, I_SLH, I_SLC, I_SSM, I_SSC, I_WADA, I_BADA, I_GF1, I_WUP1, I_WDN1, I_GMIX, I_WIN, I_LCW, I_LCB, I_LWA, I_LBA, I_LWI, I_LBI,
       I_LLAM, I_SCW, I_SCB, I_DTB, I_ALOG, I_SD, I_SNG, I_WOUT, I_GF2, I_WUP2, I_WDN2, I_WADAF, I_BADAF, I_GFIN };

__device__ __forceinline__ void p0_item(const float* W, int K, int N, bf16_t* WT, int k0, int n0, int drow0, float* scr, int lane, int kdst = -1) {
    if (kdst < 0) kdst = k0;
    const int nn = n0 + (lane & 31); const bool ok = nn < N;
    float rv[32];
    const float* wp = W + (size_t)(k0 + (lane >> 5)) * N + (ok ? nn : 0);
#pragma unroll
    for (int i = 0; i < 32; ++i) rv[i] = __builtin_nontemporal_load(wp + (size_t)(2 * i) * N);
#pragma unroll
    for (int i = 0; i < 32; ++i) { const int kk = 2 * i + (lane >> 5); scr[kk * 33 + (lane & 31)] = ok ? rv[i] : 0.f; }
    asm volatile("s_waitcnt lgkmcnt(0)" ::: "memory");
    const int c = lane & 7;
#pragma unroll
    for (int j = 0; j < 4; ++j) { const int n = (lane >> 3) + 8 * j; const float* s = scr + (8 * c) * 33 + n;
        u32x4 o; o.x = pk2(s[0 * 33], s[1 * 33]); o.y = pk2(s[2 * 33], s[3 * 33]); o.z = pk2(s[4 * 33], s[5 * 33]); o.w = pk2(s[6 * 33], s[7 * 33]);
        if (n0 + n < N) *(u32x4*)(WT + (size_t)(drow0 + n) * K + kdst + 8 * c) = o; }
    asm volatile("s_waitcnt lgkmcnt(0)" ::: "memory");
}
__device__ __forceinline__ int up_row(int n0) { return n0 < FF ? (n0 >> 7) * 256 + (n0 & 127) : ((n0 - FF) >> 7) * 256 + 128 + ((n0 - FF) & 127); }

__device__ __forceinline__ void convert_part(const AP& a, unsigned char* lds, int part, int worker, int nworkers, int lane, int wave) {
    float* scr = (float*)(lds + wave * 16384);
    unsigned char* ws = a.ws();
    constexpr int I_UP = (D / 64) * (2 * FF / 32), I_DN = (FF / 64) * (D / 32), I_IN = (D / 64) * 145, I_OUT = (D / 64) * (D / 32),
                  I_ADA = (D / 64) * (18432 / 32), I_ADAF = (D / 64) * (4096 / 32), I_G = 32;
    if (part == 0) {
        constexpr int NIT = I_ADA + I_ADAF + I_UP + 2 * I_G;
        for (int it = worker; it < NIT; it += nworkers) {
            int r = it;
            if (r < I_ADA) { const int kb = r / 576, nb = r % 576; p0_item(a.in(I_WADA), D, 18432, (bf16_t*)(ws + WS_ADA), kb * 64, nb * 32, nb * 32, scr, lane); continue; }
            r -= I_ADA;
            if (r < I_ADAF) { const int kb = r / 128, nb = r % 128; p0_item(a.in(I_WADAF), D, 4096, (bf16_t*)(ws + WS_ADA), kb * 64, nb * 32, 18432 + nb * 32, scr, lane); continue; }
            r -= I_ADAF;
            if (r < I_UP) { const int nblk = 2 * FF / 32, kb = r / nblk, nb = r % nblk; p0_item(a.in(I_WUP1), D, 2 * FF, (bf16_t*)(ws + WS_WUP1), kb * 64, nb * 32, up_row(nb * 32), scr, lane); continue; }
            r -= I_UP;
            { const int w = r >= I_G; r -= w * I_G; const int h = r >> 1, nb = r & 1;
              p0_item(a.in(w ? I_LWI : I_LWA) + h * 4096, 64, 64, (bf16_t*)(ws + (w ? WS_WIT : WS_WAT)) + h * 4096, 0, nb * 32, nb * 32, scr, lane); }
        }
    } else if (part == 1) {
        constexpr int NIT = I_DN + I_IN + I_OUT;
        for (int it = worker; it < NIT; it += nworkers) {
            int r = it;
            if (r < I_DN) { const int nblk = D / 32, kb = r / nblk, nb = r % nblk; p0_item(a.in(I_WDN1), FF, D, (bf16_t*)(ws + WS_WDN1), kb * 64, nb * 32, nb * 32, scr, lane); continue; }
            r -= I_DN;
            if (r < I_IN) { const int kb = r / 145, nb = r % 145; p0_item(a.in(I_WIN), D, INC, (bf16_t*)(ws + WS_WIN), kb * 64, nb * 32, nb * 32, scr, lane); continue; }
            r -= I_IN;
            { const int kb = r / 64, nb = r % 64; p0_item(a.in(I_WOUT), D, D, (bf16_t*)(ws + WS_WOUT), kb * 64, nb * 32, nb * 32, scr, lane, (kb * 64 + 1024) & 2047); }
        }
    } else {
        constexpr int NIT = I_UP + I_DN;
        for (int it = worker; it < NIT; it += nworkers) {
            int r = it;
            if (r < I_UP) { const int nblk = 2 * FF / 32, kb = r / nblk, nb = r % nblk; p0_item(a.in(I_WUP2), D, 2 * FF, (bf16_t*)(ws + WS_WUP2), kb * 64, nb * 32, up_row(nb * 32), scr, lane); continue; }
            r -= I_UP;
            { const int nblk = D / 32, kb = r / nblk, nb = r % nblk; p0_item(a.in(I_WDN2), FF, D, (bf16_t*)(ws + WS_WDN2), kb * 64, nb * 32, nb * 32, scr, lane); }
        }
    }
}
__device__ __forceinline__ void convert_in_tail(const AP& a, unsigned char* lds, int part, int nunits, int bx, int G, int lane, int wave) {
    const int lo = nunits % G;
    if (bx >= lo) convert_part(a, lds, part, (bx - lo) * 8 + wave, (G - lo) * 8, lane, wave);
}
__device__ __forceinline__ void phase0(const AP& a, unsigned char* lds, int gw, int NGW, int lane, int wave) {
    convert_part(a, lds, 0, gw, NGW, lane, wave);
    { unsigned* rsz = (unsigned*)(a.ws() + WS_RS); for (int i = gw * 64 + lane; i < 3 * 10240 + MP; i += NGW * 64) rsz[i] = 0u; }
    unsigned char* ws = a.ws();
    bf16_t* cact = (bf16_t*)(ws + WS_CACT);
    for (int e = gw * 64 + lane; e < (NB + NS) * D / 4; e += NGW * 64) {
        const int row = e / (D / 4), c4 = e % (D / 4);
        const float* src = row < NB ? a.in(I_CP) + (size_t)row * D : a.in(I_CS) + (size_t)(row - NB) * D;
        const f32x4 v = *(const f32x4*)(src + c4 * 4);
        u32x2 o; o.x = pk2(siluf(v.x), siluf(v.y)); o.y = pk2(siluf(v.z), siluf(v.w));
        *(u32x2*)(cact + (size_t)row * D + c4 * 4) = o;
    }
}

template <bool FINAL>
__device__ __forceinline__ void norm_phase(const float* xp, const float* xs, const float* part, int nsplit, float* xw, const float* g, const float* mod, int sh_off, int sc_off, bf16_t* H, float* outp, float* outs, int gw, int NGW, int lane, int row_begin = 0) {
    for (int row = row_begin + gw; row < MV; row += NGW) {
        const float* src = row < TP ? xp + (size_t)row * D : xs + (size_t)(row - TP) * D;
        const float* mr = mod + (size_t)batch_row(row) * NMOD;
        f32x4 v[8]; float ss = 0.f;
#pragma unroll
        for (int j = 0; j < 8; ++j) v[j] = *(const f32x4*)(src + (64 * j + lane) * 4);
        if (row >= TP && nsplit > 0) {
            const float* pp = part + (size_t)(row - TP) * D + lane * 4;
            int k = 0;
#pragma unroll 1
            for (; k + 4 <= nsplit; k += 4) { f32x4 t[4][8];
#pragma unroll
                for (int u = 0; u < 4; ++u)
#pragma unroll
                    for (int j = 0; j < 8; ++j) t[u][j] = *(const f32x4*)(pp + (size_t)(k + u) * 128 * D + 256 * j);
#pragma unroll
                for (int u = 0; u < 4; ++u)
#pragma unroll
                    for (int j = 0; j < 8; ++j) v[j] += t[u][j]; }
#pragma unroll 1
            for (; k < nsplit; ++k) {
#pragma unroll
                for (int j = 0; j < 8; ++j) v[j] += *(const f32x4*)(pp + (size_t)k * 128 * D + 256 * j); }
            if (xw) {
#pragma unroll
                for (int j = 0; j < 8; ++j) *(f32x4*)(xw + (size_t)row * D + (64 * j + lane) * 4) = v[j]; }
        }
#pragma unroll
        for (int j = 0; j < 8; ++j) ss += (v[j].x * v[j].x + v[j].y * v[j].y) + (v[j].z * v[j].z + v[j].w * v[j].w);
        const float rstd = rsqrtf(wave_sum(ss) * (1.f / D) + EPS);
#pragma unroll
        for (int j = 0; j < 8; ++j) { const int c = (64 * j + lane) * 4;
            const f32x4 gg = *(const f32x4*)(g + c), sc = *(const f32x4*)(mr + sc_off + c) + *(const f32x4*)(mr + MODB + sc_off + c), sh = *(const f32x4*)(mr + sh_off + c) + *(const f32x4*)(mr + MODB + sh_off + c);
            const f32x4 y = (v[j] * rstd * gg) * (sc + 1.f) + sh;
            if (FINAL) { float* o = row < TP ? outp + (size_t)row * D : outs + (size_t)(row - TP) * D; *(f32x4*)(o + c) = y; }
            else { u32x2 o; o.x = pk2(y.x, y.y); o.y = pk2(y.z, y.w); *(u32x2*)(H + (size_t)row * D + c) = o; } }
    }
}


__device__ __forceinline__ void norm1_prompt(const float* xp, const float* g, const float* mod, int sh_off, int sc_off, bf16_t* H, int gw, int NGW, int lane) {
#pragma unroll 1
    for (int r0 = gw * 4; r0 < TP; r0 += NGW * 4) {
        const float* mr = mod + (size_t)(r0 >> 11) * NMOD;
        f32x4 va[2][8], vb[2][8];
#pragma unroll
        for (int r = 0; r < 2; ++r)
#pragma unroll
            for (int j = 0; j < 8; ++j) va[r][j] = *(const f32x4*)(xp + (size_t)(r0 + r) * D + (64 * j + lane) * 4);
        asm volatile("" ::: "memory");
        f32x4 gs[8], sh[8];
#pragma unroll
        for (int j = 0; j < 8; ++j) { const int c = (64 * j + lane) * 4;
            gs[j] = *(const f32x4*)(g + c) * ((*(const f32x4*)(mr + sc_off + c) + *(const f32x4*)(mr + MODB + sc_off + c)) + 1.f);
            sh[j] = *(const f32x4*)(mr + sh_off + c) + *(const f32x4*)(mr + MODB + sh_off + c);
            if (j & 1) asm volatile("" ::: "memory"); }
#pragma unroll
        for (int r = 0; r < 2; ++r)
#pragma unroll
            for (int j = 0; j < 8; ++j) vb[r][j] = *(const f32x4*)(xp + (size_t)(r0 + 2 + r) * D + (64 * j + lane) * 4);
#define NORM1_ROWS(V, RB) do { _Pragma("unroll") for (int r = 0; r < 2; ++r) { float ss = 0.f; \
            _Pragma("unroll") for (int j = 0; j < 8; ++j) { const f32x4 v = V[r][j]; ss += (v.x * v.x + v.y * v.y) + (v.z * v.z + v.w * v.w); } \
            const float rstd = rsqrtf(wave_sum(ss) * (1.f / D) + EPS); \
            _Pragma("unroll") for (int j = 0; j < 8; ++j) { const f32x4 y = (V[r][j] * rstd) * gs[j] + sh[j]; \
                u32x2 o; o.x = pk2(y.x, y.y); o.y = pk2(y.z, y.w); *(u32x2*)(H + (size_t)(r0 + (RB) + r) * D + (64 * j + lane) * 4) = o; } } } while (0)
        NORM1_ROWS(va, 0);
        NORM1_ROWS(vb, 2);
#undef NORM1_ROWS
    }
}


__device__ __forceinline__ void final_sample_norm(const AP& a, unsigned char* lds, int rl, int lane, int wave) {
    unsigned char* ws = a.ws();
    const float* part = (const float*)(ws + WS_PART) + (size_t)rl * D + lane * 4;
    const float* xrow = (const float*)(ws + WS_X) + (size_t)(TP + rl) * D + lane * 4;
    constexpr int NSP = FF / KSPL;
    f32x4 v[8], t0[8], t1[8], t2[8];
#pragma unroll
    for (int j = 0; j < 8; ++j) { t0[j] = *(const f32x4*)(part + (size_t)wave * 128 * D + 256 * j);
        t1[j] = *(const f32x4*)(part + (size_t)(wave + 8) * 128 * D + 256 * j);
        t2[j] = (wave + 16 < NSP) ? *(const f32x4*)(part + (size_t)(wave + 16) * 128 * D + 256 * j) : (f32x4){0.f, 0.f, 0.f, 0.f};
        v[j] = (wave == 0) ? *(const f32x4*)(xrow + 256 * j) : (f32x4){0.f, 0.f, 0.f, 0.f}; }
    float* s_red = (float*)lds;
    float* s_ss = s_red + 8 * D;
#pragma unroll
    for (int j = 0; j < 8; ++j) *(f32x4*)(s_red + wave * D + 256 * j + lane * 4) = (v[j] + t0[j]) + (t1[j] + t2[j]);
    __syncthreads();
    const int c = wave * 256 + lane * 4;
    f32x4 x = *(const f32x4*)(s_red + c);
#pragma unroll
    for (int w = 1; w < 8; ++w) x += *(const f32x4*)(s_red + w * D + c);
    const float ss = wave_sum((x.x * x.x + x.y * x.y) + (x.z * x.z + x.w * x.w));
    if (lane == 0) s_ss[wave] = ss;
    const float* mr = (const float*)(ws + WS_MOD) + (size_t)(NB + rl) * NMOD;
    const f32x4 gg = *(const f32x4*)(a.in(I_GFIN) + c), sc = *(const f32x4*)(mr + 10 * D + c) + *(const f32x4*)(mr + MODB + 10 * D + c), sh = *(const f32x4*)(mr + 9 * D + c) + *(const f32x4*)(mr + MODB + 9 * D + c);
    __syncthreads();
    float tot = 0.f;
#pragma unroll
    for (int w = 0; w < 8; ++w) tot += s_ss[w];
    const float rstd = rsqrtf(tot * (1.f / D) + EPS);
    *(f32x4*)(a.out() + O_YS + (size_t)rl * D + c) = (x * rstd * gg) * (sc + 1.f) + sh;
}

constexpr int LD = 136;
__device__ __forceinline__ f32x4 mfma16(bf16x8 a, bf16x8 b, f32x4 c) { return __builtin_amdgcn_mfma_f32_16x16x32_bf16(a, b, c, 0, 0, 0); }

__device__ __forceinline__ void ssd_pass1(const AP& a, unsigned char* lds, int item, int tid, int lane, int wave) {
    const int hh = item & 1, g = (item >> 1) & 1, c = (item >> 2) & 15, b = item >> 6, h0 = g * 8 + hh * 4;
    const int row0 = b * SEQ + c * 128;
    unsigned char* ws = a.ws();
    const float* proj = (const float*)(ws + WS_BIG);
    bf16_t* sC = (bf16_t*)lds; bf16_t* sB = (bf16_t*)(lds + 34816); bf16_t* sBT = (bf16_t*)(lds + 69632);
    bf16_t* sXT = (bf16_t*)(lds + 34816); bf16_t* sXdT = (bf16_t*)(lds + 52224);
    float* s_cs = (float*)(lds + 104448); float* s_dt = s_cs + 512; float* s_da = s_dt + 512;
    const int l0 = wave * 16, fr = lane & 15, fq = lane >> 4;
    {
        const int hl = tid >> 7, l = tid & 127, h = h0 + hl;
        const float Ah = -expf(a.in(I_ALOG)[h]);
        const float dt = softplusf(proj[(size_t)(row0 + l) * INCP + PC_DT + h] + a.in(I_DTB)[h]); s_dt[tid] = dt; s_da[tid] = dt * Ah;
    }
    {
        const float* cw = a.in(I_SCW); const float* cb = a.in(I_SCB); bf16_t* cact2 = (bf16_t*)(ws + WS_CACT2);
#pragma unroll
        for (int cg4 = 0; cg4 < 4; ++cg4) {
            const int n = (cg4 & 1) * 64 + lane;
            const int xcol = (cg4 < 2 ? 1024 : 1280) + g * 128 + n;
            const float w0 = cw[xcol], w1 = cw[CONVD + xcol], w2 = cw[2 * CONVD + xcol], w3 = cw[3 * CONVD + xcol], bb = cb[xcol];
            const float* pcol = proj + PC_XBC + xcol;
            float pv[19];
#pragma unroll
            for (int i = 0; i < 19; ++i) { const int l = l0 - 3 + i; pv[i] = (c * 128 + l >= 0) ? pcol[(size_t)(row0 + l) * INCP] : 0.f; }
            unsigned pkv[8];
#pragma unroll
            for (int i = 0; i < 16; i += 2) {
                const float v0 = siluf(bb + w0 * pv[i] + w1 * pv[i + 1] + w2 * pv[i + 2] + w3 * pv[i + 3]), v1 = siluf(bb + w0 * pv[i + 1] + w1 * pv[i + 2] + w2 * pv[i + 3] + w3 * pv[i + 4]);
                pkv[i >> 1] = pk2(v0, v1);
            }
#pragma unroll
            for (int i = 0; i < 16; ++i) {
                const int l = l0 + i; const bf16_t v = (bf16_t)((i & 1) ? (pkv[i >> 1] >> 16) : pkv[i >> 1]);
                if (cg4 < 2) sB[l * LD + n] = v;
                else { sC[l * LD + n] = v; if (hh == 0) cact2[(size_t)(row0 + l) * 256 + g * 128 + n] = v; }
            }
            if (cg4 < 2) { *(u32x4*)(sBT + n * LD + l0) = (u32x4){pkv[0], pkv[1], pkv[2], pkv[3]}; *(u32x4*)(sBT + n * LD + l0 + 8) = (u32x4){pkv[4], pkv[5], pkv[6], pkv[7]}; }
        }
    }
    __syncthreads();
    {
        const int hl = tid >> 7, l = tid & 127; float v = s_da[tid];
#pragma unroll
        for (int o = 1; o < 64; o <<= 1) { const float t = __shfl_up(v, o); v += (lane >= o) ? t : 0.f; }
        if (l >= 64) v += wave_sum(s_da[hl * 128 + lane]);
        s_cs[tid] = v; ((float*)(ws + WS_CS))[(size_t)(row0 + l) * 16 + h0 + hl] = v;
        if (l == 127) ((float*)(ws + WS_CD))[(b * NCH + c) * 16 + h0 + hl] = __expf(v);
    }
    const int stmax = wave | 1, kmax = (wave * 16 + 15) >> 5;
    f32x4 cbv[8];
    {
        bf16x8 af[4];
#pragma unroll
        for (int kk = 0; kk < 4; ++kk) af[kk] = *(const bf16x8*)(sC + (l0 + fr) * LD + kk * 32 + fq * 8);
#pragma unroll
        for (int st = 0; st < 8; ++st) {
            cbv[st] = (f32x4){0.f, 0.f, 0.f, 0.f};
            if (st <= stmax) {
#pragma unroll
                for (int kk = 0; kk < 4; ++kk) { const bf16x8 bfv = *(const bf16x8*)(sB + (st * 16 + fr) * LD + kk * 32 + fq * 8); cbv[st] = mfma16(af[kk], bfv, cbv[st]); }
            }
        }
    }
    __syncthreads();
    bf16_t* sM = sC;
    bf16_t* xs_g = (bf16_t*)(ws + WS_XS); float* ypart = (float*)(ws + WS_YPART);
    const float* cw = a.in(I_SCW); const float* cb = a.in(I_SCB);
    float pvn[19];
#define SSD_LOADX(hl_) do { const float* pc_ = proj + (size_t)(row0 + l0 - 3) * INCP + PC_XBC + (h0 + (hl_)) * 64 + lane; \
        _Pragma("unroll") for (int i = 0; i < 19; ++i) pvn[i] = (c * 128 + l0 - 3 + i >= 0) ? pc_[(size_t)i * INCP] : 0.f; } while (0)
    SSD_LOADX(0);
#pragma unroll 1
    for (int hl = 0; hl < 4; ++hl) {
        const int h = h0 + hl;
        const float* cs = s_cs + hl * 128; const float* dts = s_dt + hl * 128;
        const float cs_last = cs[127];
        {
            const int xcol = h * 64 + lane;
            const float w0 = cw[xcol], w1 = cw[CONVD + xcol], w2 = cw[2 * CONVD + xcol], w3 = cw[3 * CONVD + xcol], bb = cb[xcol];
            float pv[19];
#pragma unroll
            for (int i = 0; i < 19; ++i) pv[i] = pvn[i];
            if (hl < 3) SSD_LOADX(hl + 1);
            unsigned pkx[8], pkd[8];
#pragma unroll
            for (int i = 0; i < 16; i += 2) {
                const int l = l0 + i;
                const float v0 = siluf(bb + w0 * pv[i] + w1 * pv[i + 1] + w2 * pv[i + 2] + w3 * pv[i + 3]), v1 = siluf(bb + w0 * pv[i + 1] + w1 * pv[i + 2] + w2 * pv[i + 3] + w3 * pv[i + 4]);
                const float x0 = v0 * dts[l], x1 = v1 * dts[l + 1];
                pkx[i >> 1] = pk2(x0, x1); pkd[i >> 1] = pk2(x0 * __expf(cs_last - cs[l]), x1 * __expf(cs_last - cs[l + 1]));
                const unsigned pv2 = pk2(v0, v1);
                xs_g[(size_t)(row0 + l) * 1024 + xcol] = (bf16_t)pv2; xs_g[(size_t)(row0 + l + 1) * 1024 + xcol] = (bf16_t)(pv2 >> 16);
            }
            *(u32x4*)(sXT + lane * LD + l0) = (u32x4){pkx[0], pkx[1], pkx[2], pkx[3]}; *(u32x4*)(sXT + lane * LD + l0 + 8) = (u32x4){pkx[4], pkx[5], pkx[6], pkx[7]};
            *(u32x4*)(sXdT + lane * LD + l0) = (u32x4){pkd[0], pkd[1], pkd[2], pkd[3]}; *(u32x4*)(sXdT + lane * LD + l0 + 8) = (u32x4){pkd[4], pkd[5], pkd[6], pkd[7]};
        }
#pragma unroll
        for (int st = 0; st < 8; ++st) {
            if (st <= stmax) {
                const int sidx = st * 16 + fr; const float css = cs[sidx];
#pragma unroll
                for (int i = 0; i < 4; ++i) { const int l = l0 + fq * 4 + i;
                    const float mv = (sidx <= l) ? cbv[st][i] * __expf(cs[l] - css) : 0.f;
                    sM[l * LD + sidx] = (bf16_t)f2bf(mv); }
            }
        }
        __syncthreads();
#pragma unroll
        for (int pt = 0; pt < 4; ++pt) {
            f32x4 y = (f32x4){0.f, 0.f, 0.f, 0.f};
#pragma unroll
            for (int kk = 0; kk < 4; ++kk) if (kk <= kmax) {
                const bf16x8 am = *(const bf16x8*)(sM + (l0 + fr) * LD + kk * 32 + fq * 8);
                const bf16x8 bx = *(const bf16x8*)(sXT + (pt * 16 + fr) * LD + kk * 32 + fq * 8);
                y = mfma16(am, bx, y); }
#pragma unroll
            for (int i = 0; i < 4; ++i) ypart[(size_t)(row0 + l0 + fq * 4 + i) * 1024 + h * 64 + pt * 16 + fr] = y[i];
        }
        float* st_g = (float*)(ws + WS_ST) + (size_t)((b * NCH + c) * NH + h) * (HP * NST);
#pragma unroll
        for (int pt = 0; pt < 4; ++pt) {
            f32x4 sacc = (f32x4){0.f, 0.f, 0.f, 0.f};
#pragma unroll
            for (int kk = 0; kk < 4; ++kk) {
                const bf16x8 ax = *(const bf16x8*)(sXdT + (pt * 16 + fr) * LD + kk * 32 + fq * 8);
                const bf16x8 bb2 = *(const bf16x8*)(sBT + (wave * 16 + fr) * LD + kk * 32 + fq * 8);
                sacc = mfma16(ax, bb2, sacc); }
#pragma unroll
            for (int i = 0; i < 4; ++i) st_g[(pt * 16 + fq * 4 + i) * NST + wave * 16 + fr] = sacc[i];
        }
        __syncthreads();
    }
}

__device__ __forceinline__ void lru_pass1_all(const AP& a, unsigned char* lds, int bx, int G, int lane, int wave) {
    constexpr int NIT = NB * NCH * NH;
    if (bx >= NIT) return;
    unsigned char* ws = a.ws();
    const float* proj = (const float*)(ws + WS_BIG);
    float* s_xc = (float*)lds;
    bf16_t* s_xb = (bf16_t*)(lds + 33280);
    float* s_a = (float*)(lds + 51712);
    float* s_b = (float*)(lds + 84992);
    float* s_ag = (float*)(lds + 118272);
    bf16_t* acum = (bf16_t*)(ws + WS_ACUM); bf16_t* hloc = (bf16_t*)(ws + WS_HLOC);
    const int l0 = wave * 16, fr = lane & 15, fq = lane >> 4;
    int hcur = -1, par = 0;
    float w0 = 0.f, w1 = 0.f, w2 = 0.f, w3 = 0.f, bb = 0.f;
    float bav[4], biv[4], sp[4]; bf16x8 ba[4][2], bi[4][2];
    float pvn[19];
#define LRU_LOADPV(it_) do { const int h_ = (it_) & 15, c_ = ((it_) >> 4) & 15, b_ = (it_) >> 8; const float* pc_ = proj + (size_t)(b_ * SEQ + c_ * 128 + l0 - 3) * INCP + PC_XL + h_ * 64 + lane; \
        _Pragma("unroll") for (int i = 0; i < 19; ++i) pvn[i] = (c_ * 128 + l0 - 3 + i >= 0) ? pc_[(size_t)i * INCP] : 0.f; } while (0)
    LRU_LOADPV(bx);
#pragma unroll 1
    for (int it = bx; it < NIT; it += G) {
        const int h = it & 15, c = (it >> 4) & 15, b = it >> 8, row0 = b * SEQ + c * 128, ch = h * 64 + lane;
        if (h != hcur) {
            hcur = h;
            const float* cw = a.in(I_LCW); w0 = cw[ch]; w1 = cw[WL + ch]; w2 = cw[2 * WL + ch]; w3 = cw[3 * WL + ch]; bb = a.in(I_LCB)[ch];
            const bf16_t* waT = (const bf16_t*)(ws + WS_WAT) + h * 4096; const bf16_t* wiT = (const bf16_t*)(ws + WS_WIT) + h * 4096;
#pragma unroll
            for (int jt = 0; jt < 4; ++jt) { const int cj = h * 64 + jt * 16 + fr; bav[jt] = a.in(I_LBA)[cj]; biv[jt] = a.in(I_LBI)[cj]; sp[jt] = softplusf(-a.in(I_LLAM)[cj]);
#pragma unroll
                for (int kk = 0; kk < 2; ++kk) { ba[jt][kk] = *(const bf16x8*)(waT + (jt * 16 + fr) * 64 + kk * 32 + fq * 8); bi[jt][kk] = *(const bf16x8*)(wiT + (jt * 16 + fr) * 64 + kk * 32 + fq * 8); } }
        }
        float pv[19];
#pragma unroll
        for (int i = 0; i < 19; ++i) pv[i] = pvn[i];
        if (it + G < NIT) LRU_LOADPV(it + G);
#pragma unroll
        for (int i = 0; i < 16; ++i) { const int l = l0 + i;
            const float v = bb + w0 * pv[i] + w1 * pv[i + 1] + w2 * pv[i + 2] + w3 * pv[i + 3];
            s_xc[l * 65 + lane] = v; s_xb[l * 72 + lane] = (bf16_t)f2bf(v); }
        asm volatile("s_waitcnt lgkmcnt(0)" ::: "memory");
        {
            bf16x8 af[2];
#pragma unroll
            for (int kk = 0; kk < 2; ++kk) af[kk] = *(const bf16x8*)(s_xb + (l0 + fr) * 72 + kk * 32 + fq * 8);
#pragma unroll
            for (int jt = 0; jt < 4; ++jt) {
                f32x4 ra = (f32x4){0.f, 0.f, 0.f, 0.f}, ri = ra;
#pragma unroll
                for (int kk = 0; kk < 2; ++kk) { ra = mfma16(af[kk], ba[jt][kk], ra); ri = mfma16(af[kk], bi[jt][kk], ri); }
                const int j = jt * 16 + fr;
#pragma unroll
                for (int i = 0; i < 4; ++i) { const int l = l0 + fq * 4 + i;
                    const float r = sigm(ra[i] + bav[jt]), ig = sigm(ri[i] + biv[jt]);
                    const float la = -8.0f * r * sp[jt]; const float av = __expf(la);
                    const float bt = __builtin_sqrtf(1.f - av * av) * (ig * s_xc[l * 65 + j]);
                    s_a[l * 65 + j] = av; s_b[l * 65 + j] = bt; }
            }
        }
        asm volatile("s_waitcnt lgkmcnt(0)" ::: "memory");
        float sa[16], sb[16];
#pragma unroll
        for (int i = 0; i < 16; ++i) { sa[i] = s_a[(l0 + i) * 65 + lane]; sb[i] = s_b[(l0 + i) * 65 + lane]; }
        float A = 1.f, Bv = 0.f;
#pragma unroll
        for (int i = 0; i < 16; ++i) { A *= sa[i]; Bv = sa[i] * Bv + sb[i]; sa[i] = A; sb[i] = Bv; }
        float* ag = s_ag + par * 1024;
        ag[(wave * 64 + lane) * 2] = A; ag[(wave * 64 + lane) * 2 + 1] = Bv;
        __syncthreads();
        float Ain = 1.f, Bin = 0.f;
        for (int sg = 0; sg < wave; ++sg) { const float As = ag[(sg * 64 + lane) * 2], Bs = ag[(sg * 64 + lane) * 2 + 1]; Bin = As * Bin + Bs; Ain *= As; }
        float ac = 0.f, hl = 0.f;
#pragma unroll
        for (int i = 0; i < 16; ++i) { ac = Ain * sa[i]; hl = sa[i] * Bin + sb[i];
            acum[(size_t)(row0 + l0 + i) * 1024 + ch] = (bf16_t)f2bf(ac); hloc[(size_t)(row0 + l0 + i) * 1024 + ch] = (bf16_t)f2bf(hl); }
        if (wave == 7) { ((float*)(ws + WS_AGA))[(b * NCH + c) * 1024 + ch] = ac; ((float*)(ws + WS_AGB))[(b * NCH + c) * 1024 + ch] = hl; }
        par ^= 1;
    }
    __syncthreads();
#undef LRU_LOADPV
}

__device__ __forceinline__ void ssd_sample(const AP& a, unsigned char* lds, int item, int lane, int wave) {
    const int h = item & 15, b = item >> 4, g = h >> 3;
    unsigned char* ws = a.ws();
    const float* prow = (const float*)(ws + WS_BIG) + (size_t)(TP + b) * INCP;
    float* s_v = (float*)(lds + wave * 16384);
    f32x4 hvs[2][16];
    { const float* h0e = a.in(I_SSM) + (size_t)(b * NH + h) * (HP * NST) + (lane >> 5) * NST + (lane & 31) * 4;
#pragma unroll
      for (int i = 0; i < 32; ++i) hvs[i >> 4][i & 15] = __builtin_nontemporal_load((const f32x4*)(h0e + (size_t)i * 2 * NST)); }
    {
        const float* cw = a.in(I_SCW); const float* cb = a.in(I_SCB); const float* stc = a.in(I_SSC) + (size_t)b * 3 * CONVD;
#pragma unroll
        for (int q = 0; q < 5; ++q) {
            const int lc = q * 64 + lane;
            const int xcol = q == 0 ? h * 64 + lc : (q < 3 ? 1024 + g * 128 + (lc - 64) : 1280 + g * 128 + (lc - 192));
            const float v = cb[xcol] + cw[xcol] * stc[xcol] + cw[CONVD + xcol] * stc[CONVD + xcol] + cw[2 * CONVD + xcol] * stc[2 * CONVD + xcol] + cw[3 * CONVD + xcol] * prow[PC_XBC + xcol];
            s_v[lc] = siluf(v);
        }
        s_v[320 + lane] = bf2f(((const bf16_t*)(ws + WS_ZB))[(size_t)(TP + b) * 1024 + h * 64 + lane]);
    }
    const float dt = softplusf(prow[PC_DT + h] + a.in(I_DTB)[h]);
    const float dA = expf(dt * -expf(a.in(I_ALOG)[h])), Dh = a.in(I_SD)[h];
    asm volatile("s_waitcnt lgkmcnt(0)" ::: "memory");
    const int n4 = (lane & 31) * 4, ph = lane >> 5;
    f32x4 Bv, Cv;
#pragma unroll
    for (int j = 0; j < 4; ++j) { Bv[j] = s_v[64 + n4 + j]; Cv[j] = s_v[192 + n4 + j]; }
    const float* h0 = a.in(I_SSM) + (size_t)(b * NH + h) * (HP * NST) + ph * NST + n4;
    float* ho = a.out() + O_SSMS + (size_t)(b * NH + h) * (HP * NST) + ph * NST + n4;
    bf16_t* a2row = (bf16_t*)(ws + WS_H) + (size_t)(TP + b) * D + h * 64; const float* gnh = a.in(I_SNG) + h * 64;
    float ssq = 0.f;
#pragma unroll
    for (int half = 0; half < 2; ++half) {
#pragma unroll
        for (int i = 0; i < 16; ++i) {
            const int p = (half * 16 + i) * 2 + ph;
            const float xv = s_v[p], xdt = xv * dt;
            const f32x4 hn = hvs[half][i] * dA + Bv * xdt;
            __builtin_nontemporal_store(hn, (f32x4*)(ho + (size_t)(half * 16 + i) * 2 * NST));
            float yp = (hn.x * Cv.x + hn.y * Cv.y) + (hn.z * Cv.z + hn.w * Cv.w);
            yp += __shfl_xor(yp, 1); yp += __shfl_xor(yp, 2); yp += __shfl_xor(yp, 4); yp += __shfl_xor(yp, 8); yp += __shfl_xor(yp, 16);
            if ((lane & 31) == 0) { const float yg = (yp + Dh * xv) * siluf(s_v[320 + p]); a2row[p] = (bf16_t)f2bf(yg * gnh[p]); ssq += yg * yg; }
        }
    }
    ssq += __shfl_xor(ssq, 32);
    if (lane == 0) __hip_atomic_fetch_add((float*)(ws + WS_RSSQ) + TP + b, ssq, __ATOMIC_RELAXED, __HIP_MEMORY_SCOPE_AGENT);
    asm volatile("s_waitcnt lgkmcnt(0)" ::: "memory");
}

__device__ __forceinline__ void lru_sample(const AP& a, unsigned char* lds, int item, int tid, int lane, int wave) {
    const int P = item * 8 + wave, b = P >> 4, h = P & 15, j = lane, ch = h * 64 + j;
    unsigned char* ws = a.ws();
    const float* prow = (const float*)(ws + WS_BIG) + (size_t)(TP + b) * INCP;
    float* s_x = (float*)lds;
    const float* cw = a.in(I_LCW); const float* stc = a.in(I_SLC) + (size_t)b * 3 * WL;
    const float xc = a.in(I_LCB)[ch] + cw[ch] * stc[ch] + cw[WL + ch] * stc[WL + ch] + cw[2 * WL + ch] * stc[2 * WL + ch] + cw[3 * WL + ch] * prow[PC_XL + ch];
    s_x[tid] = xc;
    __syncthreads();
    const float* wa = a.in(I_LWA) + h * 4096 + j; const float* wi = a.in(I_LWI) + h * 4096 + j;
    float ra = a.in(I_LBA)[ch], ri = a.in(I_LBI)[ch];
#pragma unroll 32
    for (int i = 0; i < 64; ++i) { const float xv = s_x[wave * 64 + i]; ra += xv * wa[i * 64]; ri += xv * wi[i * 64]; }
    const float r = sigm(ra), ig = sigm(ri), sp = softplusf(-a.in(I_LLAM)[ch]);
    const float la = -8.0f * r * sp, av = expf(la), bt = sqrtf(-expm1f(2.f * la)) * (ig * xc);
    const float hn = av * a.in(I_SLH)[(size_t)b * WL + ch] + bt;
    a.out()[O_LHS + (size_t)b * WL + ch] = hn;
    ((bf16_t*)(ws + WS_H))[(size_t)(TP + b) * D + 1024 + ch] = (bf16_t)f2bf(hn * gelu_tanh(bf2f(((const bf16_t*)(ws + WS_GLB))[(size_t)(TP + b) * 1024 + ch])));
    __syncthreads();
}

__device__ __forceinline__ void conv_state_out(const AP& a, int gtid, int gthreads) {
    const float* proj = (const float*)(a.ws() + WS_BIG);
    for (int e = gtid; e < NB * 3 * WL; e += gthreads) { const int ch = e % WL, k = (e / WL) % 3, b = e / (3 * WL); a.out()[O_LCP + e] = proj[(size_t)(b * SEQ + SEQ - 3 + k) * INCP + PC_XL + ch]; }
    for (int e = gtid; e < NB * 3 * CONVD; e += gthreads) { const int ch = e % CONVD, k = (e / CONVD) % 3, b = e / (3 * CONVD); a.out()[O_SCP + e] = proj[(size_t)(b * SEQ + SEQ - 3 + k) * INCP + PC_XBC + ch]; }
    for (int e = gtid; e < NS * 3 * WL; e += gthreads) { const int ch = e % WL, k = (e / WL) % 3, b = e / (3 * WL);
        a.out()[O_LCS + e] = k < 2 ? a.in(I_SLC)[(size_t)(b * 3 + k + 1) * WL + ch] : proj[(size_t)(TP + b) * INCP + PC_XL + ch]; }
    for (int e = gtid; e < NS * 3 * CONVD; e += gthreads) { const int ch = e % CONVD, k = (e / CONVD) % 3, b = e / (3 * CONVD);
        a.out()[O_SCS + e] = k < 2 ? a.in(I_SSC)[(size_t)(b * 3 + k + 1) * CONVD + ch] : proj[(size_t)(TP + b) * INCP + PC_XBC + ch]; }
}

__device__ __forceinline__ void ssd_pass2(const AP& a, unsigned char* lds, int item, int tid, int lane, int wave) {
    const int h = item & 15, cq = (item >> 4) & 3, b = item >> 6, g = h >> 3;
    unsigned char* ws = a.ws();
    bf16_t* sC = (bf16_t*)lds; bf16_t* sH = (bf16_t*)(lds + 34816); float* s_cs = (float*)(lds + 52224);
    const float* stb = (const float*)(ws + WS_ST) + (size_t)(b * NCH * NH + h) * (HP * NST);
    const float* cd = (const float*)(ws + WS_CD) + b * NCH * 16 + h;
    f32x4 hv[4];
#pragma unroll
    for (int q = 0; q < 4; ++q) hv[q] = (f32x4){0.f, 0.f, 0.f, 0.f};
#pragma unroll 1
    for (int cp = 0; cp < 4 * cq; cp += 4) {
        f32x4 sv[4][4]; float dec[4];
#pragma unroll
        for (int u = 0; u < 4; ++u) { dec[u] = cd[(cp + u) * 16]; const float* sp = stb + (size_t)(cp + u) * (NH * HP * NST);
#pragma unroll
            for (int q = 0; q < 4; ++q) sv[u][q] = *(const f32x4*)(sp + (q * 512 + tid) * 4); }
#pragma unroll
        for (int u = 0; u < 4; ++u)
#pragma unroll
            for (int q = 0; q < 4; ++q) hv[q] = hv[q] * dec[u] + sv[u][q];
    }
    const int fr = lane & 15, fq = lane >> 4;
    float* ypart = (float*)(ws + WS_YPART); const bf16_t* xs_g = (const bf16_t*)(ws + WS_XS); const bf16_t* zb = (const bf16_t*)(ws + WS_ZB);
    const bf16_t* cact2 = (const bf16_t*)(ws + WS_CACT2);
    const float Dh = a.in(I_SD)[h];
    bf16_t* A2 = (bf16_t*)(ws + WS_H); float gnv[4];
#pragma unroll
    for (int pt = 0; pt < 4; ++pt) gnv[pt] = a.in(I_SNG)[h * 64 + pt * 16 + fr];
    u32x4 ct[4]; float csv = 0.f; f32x4 stv[4]; float dec = 0.f;
#define SSD2_LOADSTEP(c_) do { const int r0_ = b * SEQ + (c_) * 128; \
        _Pragma("unroll") for (int q = 0; q < 4; ++q) { const int e = q * 512 + tid, l = e >> 4, k8 = (e & 15) * 8; ct[q] = *(const u32x4*)(cact2 + (size_t)(r0_ + l) * 256 + g * 128 + k8); } \
        if (tid < 128) csv = ((const float*)(ws + WS_CS))[(size_t)(r0_ + tid) * 16 + h]; \
        dec = cd[(c_) * 16]; { const float* sp = stb + (size_t)(c_) * (NH * HP * NST); _Pragma("unroll") for (int q = 0; q < 4; ++q) stv[q] = *(const f32x4*)(sp + (q * 512 + tid) * 4); } } while (0)
    SSD2_LOADSTEP(cq * 4);
#pragma unroll 1
    for (int cc = 0; cc < 4; ++cc) {
        const int c = cq * 4 + cc, row0 = b * SEQ + c * 128;
#pragma unroll
        for (int q = 0; q < 4; ++q) { const int e = (q * 512 + tid) * 4, p = e >> 7, n = e & 127; u32x2 o; o.x = pk2(hv[q].x, hv[q].y); o.y = pk2(hv[q].z, hv[q].w); *(u32x2*)(sH + p * LD + n) = o; }
#pragma unroll
        for (int q = 0; q < 4; ++q) { const int e = q * 512 + tid, l = e >> 4, k8 = (e & 15) * 8; *(u32x4*)(sC + l * LD + k8) = ct[q]; }
        if (tid < 128) s_cs[tid] = csv;
        f32x4 stc[4]; const float decc = dec;
#pragma unroll
        for (int q = 0; q < 4; ++q) stc[q] = stv[q];
        float yp[4][4]; unsigned xz[4][4];
#pragma unroll
        for (int pt = 0; pt < 4; ++pt)
#pragma unroll
            for (int i = 0; i < 4; ++i) { const size_t row = (size_t)(row0 + wave * 16 + fq * 4 + i); const int col = h * 64 + pt * 16 + fr;
                yp[pt][i] = ypart[row * 1024 + col]; xz[pt][i] = (unsigned)xs_g[row * 1024 + col] | ((unsigned)zb[row * 1024 + col] << 16); }
        if (cc < 3) SSD2_LOADSTEP(c + 1);
        __syncthreads();
        bf16x8 af[4];
#pragma unroll
        for (int kk = 0; kk < 4; ++kk) af[kk] = *(const bf16x8*)(sC + (wave * 16 + fr) * LD + kk * 32 + fq * 8);
        float ssq[4] = {0.f, 0.f, 0.f, 0.f};
#pragma unroll
        for (int pt = 0; pt < 4; ++pt) {
            f32x4 y = (f32x4){0.f, 0.f, 0.f, 0.f};
#pragma unroll
            for (int kk = 0; kk < 4; ++kk) { const bf16x8 bh = *(const bf16x8*)(sH + (pt * 16 + fr) * LD + kk * 32 + fq * 8); y = mfma16(af[kk], bh, y); }
#pragma unroll
            for (int i = 0; i < 4; ++i) { const int l = wave * 16 + fq * 4 + i; const size_t row = (size_t)(row0 + l); const int col = h * 64 + pt * 16 + fr;
                const float yv = __expf(s_cs[l]) * y[i] + yp[pt][i] + Dh * bf2f(xz[pt][i] & 0xffffu);
                const float yg = yv * siluf(bf2f(xz[pt][i] >> 16));
                A2[row * D + col] = (bf16_t)f2bf(yg * gnv[pt]); ssq[i] += yg * yg; }
        }
#pragma unroll
        for (int i = 0; i < 4; ++i) { float sq = ssq[i]; sq += __shfl_xor(sq, 1); sq += __shfl_xor(sq, 2); sq += __shfl_xor(sq, 4); sq += __shfl_xor(sq, 8);
            if (fr == 0) __hip_atomic_fetch_add((float*)(ws + WS_RSSQ) + row0 + wave * 16 + fq * 4 + i, sq, __ATOMIC_RELAXED, __HIP_MEMORY_SCOPE_AGENT); }
#pragma unroll
        for (int q = 0; q < 4; ++q) hv[q] = hv[q] * decc + stc[q];
        if (c == NCH - 1) { float* o = a.out() + O_SSMP + (size_t)(b * NH + h) * (HP * NST);
#pragma unroll
            for (int q = 0; q < 4; ++q) *(f32x4*)(o + (q * 512 + tid) * 4) = hv[q]; }
        __syncthreads();
    }
#undef SSD2_LOADSTEP
}

__device__ __forceinline__ void lru_pass2(const AP& a, int item, int tid) {
    const int seg = item & 7, c = (item >> 3) & 15, b = item >> 7;
    unsigned char* ws = a.ws();
    const int ch = tid * 2;
    const float* aga = (const float*)(ws + WS_AGA) + (size_t)b * NCH * 1024 + ch; const float* agb = (const float*)(ws + WS_AGB) + (size_t)b * NCH * 1024 + ch;
    const bf16_t* acum = (const bf16_t*)(ws + WS_ACUM); const bf16_t* hloc = (const bf16_t*)(ws + WS_HLOC); const bf16_t* glb = (const bf16_t*)(ws + WS_GLB);
    bf16_t* A2 = (bf16_t*)(ws + WS_H);
    const int row0 = b * SEQ + c * 128 + seg * 16;
    f32x2 Av[15], Bv[15];
#pragma unroll
    for (int cp = 0; cp < 15; ++cp) { Av[cp] = *(const f32x2*)(aga + cp * 1024); Bv[cp] = *(const f32x2*)(agb + cp * 1024); }
    unsigned acp[16], hlp[16], glp[16];
#pragma unroll
    for (int i = 0; i < 16; ++i) { const size_t row = (size_t)(row0 + i);
        acp[i] = *(const unsigned*)(acum + row * 1024 + ch); hlp[i] = *(const unsigned*)(hloc + row * 1024 + ch); glp[i] = *(const unsigned*)(glb + row * 1024 + ch); }
    f32x2 Hin = (f32x2){0.f, 0.f};
#pragma unroll
    for (int cp = 0; cp < 15; ++cp) { const f32x2 hn = Av[cp] * Hin + Bv[cp]; Hin = cp < c ? hn : Hin; }
#pragma unroll
    for (int i = 0; i < 16; ++i) { const size_t row = (size_t)(row0 + i);
        const f32x2 ac = (f32x2){bf2f(acp[i] & 0xffffu), bf2f(acp[i] >> 16)}, hl = (f32x2){bf2f(hlp[i] & 0xffffu), bf2f(hlp[i] >> 16)}, gl = (f32x2){bf2f(glp[i] & 0xffffu), bf2f(glp[i] >> 16)};
        const f32x2 hv = ac * Hin + hl;
        *(unsigned*)(A2 + row * D + 1024 + ch) = pk2(hv.x * gelu_tanh(gl.x), hv.y * gelu_tanh(gl.y));
        if (c == NCH - 1 && seg == 7 && i == 15) *(f32x2*)(a.out() + O_LHP + (size_t)b * WL + ch) = hv; }
}

__device__ __forceinline__ void ssd_norm(const AP& a, int gw, int NGW, int lane) {
    unsigned char* ws = a.ws();
    const float* ssq = (const float*)(ws + WS_SSQ); bf16_t* A2 = (bf16_t*)(ws + WS_H);
    for (int row = gw; row < MV; row += NGW) {
        u32x4 v[2];
#pragma unroll
        for (int j = 0; j < 2; ++j) v[j] = *(const u32x4*)(A2 + (size_t)row * D + 1024 + (64 * j + lane) * 8);
        float s = lane < 16 ? ssq[(size_t)row * 16 + lane] : 0.f; s = wave_sum(s);
        const float rstd = rsqrtf(s * (1.f / 1024.f) + EPS);
#pragma unroll
        for (int j = 0; j < 2; ++j) { u32x4 o;
#pragma unroll
            for (int q = 0; q < 4; ++q) o[q] = pk2(bf2f(v[j][q] & 0xffffu) * rstd, bf2f(v[j][q] >> 16) * rstd);
            *(u32x4*)(A2 + (size_t)row * D + 1024 + (64 * j + lane) * 8) = o; }
    }
}

#define LAS __attribute__((address_space(3)))
#define XB_TMO      128
#define XB_XCNT(j)  (256  + 64 * (j))
#define XB_XSUB(j)  (1280 + 64 * (j))
#define XB_XGEN(j)  (2304 + 64 * (j))
#define XB_TOP      3328
#define XB_TOPGEN   3392
#define XCD_BAR_WORDS 3456
#define XB_SPIN_CAP (1u << 18)
__device__ __forceinline__ unsigned xb_ld(unsigned* p)              { return __hip_atomic_load(p, __ATOMIC_RELAXED, __HIP_MEMORY_SCOPE_AGENT); }
__device__ __forceinline__ unsigned xb_add(unsigned* p, unsigned v) { return __hip_atomic_fetch_add(p, v, __ATOMIC_RELAXED, __HIP_MEMORY_SCOPE_AGENT); }
__device__ __forceinline__ unsigned xb_xcc_id() { return (unsigned)__builtin_amdgcn_s_getreg((3 << 11) | 20) & 0xFu; }
#define XB_SPIN(cond, bar) do { unsigned _sp = 0; while (cond) { __builtin_amdgcn_s_sleep(1); \
    if ((++_sp & 255u) == 0u) { if (xb_ld(&(bar)[XB_TMO])) break; if (_sp > XB_SPIN_CAP) { atomicAdd(&(bar)[XB_TMO], 1u); break; } } } } while (0)
struct XcdBarrier { unsigned* bar; unsigned x; volatile LAS unsigned* st; };
__device__ __forceinline__ XcdBarrier xcd_barrier_post(unsigned* bar, volatile LAS unsigned* st) {
    XcdBarrier b; b.bar = bar; b.x = xb_xcc_id(); b.st = st;
    if (threadIdx.x == 0) (void)xb_add(&bar[XB_XCNT(b.x)], 1u);
    return b;
}
__device__ __forceinline__ void xcd_barrier_complete(unsigned* bar, unsigned x, unsigned& nloc, unsigned& nx) {
    const unsigned G = gridDim.x * gridDim.y * gridDim.z;
    unsigned sum, cnt, mine, sp = 0u;
    for (;;) {
        sum = 0u; cnt = 0u; mine = 0u;
#pragma unroll
        for (unsigned j = 0; j < 16; ++j) { const unsigned c = xb_ld(&bar[XB_XCNT(j)]); sum += c; cnt += (c > 0u) ? 1u : 0u; mine = (j == x) ? c : mine; }
        if (sum == G) break;
        __builtin_amdgcn_s_sleep(1);
        if ((++sp & 255u) == 0u) { if (xb_ld(&bar[XB_TMO])) break; if (sp > XB_SPIN_CAP) { atomicAdd(&bar[XB_TMO], 1u); break; } }
    }
    nloc = mine > 0u ? mine : 1u; nx = cnt > 0u ? cnt : 1u;
}
__device__ __forceinline__ void xcd_barrier(const XcdBarrier& b) {
    asm volatile("s_waitcnt vmcnt(0)" ::: "memory");
    __syncthreads();
    if (threadIdx.x == 0) {
        unsigned* bar = b.bar;
        __builtin_amdgcn_s_waitcnt(0);
        unsigned nloc = b.st[0], nx = b.st[1];
        if (nloc == 0u) { xcd_barrier_complete(bar, b.x, nloc, nx); b.st[0] = nloc; b.st[1] = nx; }
        const unsigned old = xb_add(&bar[XB_XSUB(b.x)], 1u);
        const unsigned gen = old / nloc;
        if (old + 1u == (gen + 1u) * nloc) {
            __builtin_amdgcn_fence(__ATOMIC_RELEASE, "agent");
            asm volatile("s_waitcnt vmcnt(0)" ::: "memory");
            const unsigned og = xb_add(&bar[XB_TOP], 1u);
            const unsigned tg = og / nx;
            if (og + 1u == (tg + 1u) * nx) xb_add(&bar[XB_TOPGEN], 1u);
            else XB_SPIN(xb_ld(&bar[XB_TOPGEN]) == tg, bar);
            __builtin_amdgcn_fence(__ATOMIC_ACQUIRE, "agent");
            xb_add(&bar[XB_XGEN(b.x)], 1u);
            asm volatile("s_waitcnt vmcnt(0)" ::: "memory");
        } else {
            XB_SPIN(xb_ld(&bar[XB_XGEN(b.x)]) == gen, bar);
            __builtin_amdgcn_fence(__ATOMIC_ACQUIRE, "agent");
            asm volatile("s_waitcnt vmcnt(0)" ::: "memory");
        }
    }
    __syncthreads();
}

constexpr int LDS_BYTES = 147456;
__global__ void __launch_bounds__(512, 2) hymba_fwd(Args kargs) {
    extern __shared__ __attribute__((aligned(16))) unsigned char lds[];
    cg::grid_group grid = cg::this_grid();
    const int G = gridDim.x, bx = blockIdx.x, NGW = G * 8;
#define TIDS() int tid = threadIdx.x; asm volatile("" : "+v"(tid)); const int lane = tid & 63, wave = __builtin_amdgcn_readfirstlane(tid >> 6), gw = bx * 8 + wave; (void)lane; (void)gw
    {   TIDS();
        const unsigned long long* ka = (const unsigned long long*)__builtin_amdgcn_kernarg_segment_ptr();
        if (tid < 37) ((unsigned long long*)(lds + ARGTAB_OFF))[tid] = ka[tid];
        __syncthreads();
    }
    AP a; a.tab = (const unsigned*)(lds + ARGTAB_OFF);
    volatile LAS unsigned* bst = (volatile LAS unsigned*)(lds + 131072 + 512);
    {   TIDS();
        if (tid == 0) { bst[0] = 0u; bst[1] = 0u; }
        if (kargs.never) grid.sync();
        (void)xcd_barrier_post((unsigned*)(a.ws() + WS_CTL), bst);
    }
#define GBAR() do { XcdBarrier xb_; xb_.bar = (unsigned*)(a.ws() + WS_CTL); xb_.x = xb_xcc_id(); xb_.st = bst; xcd_barrier(xb_); } while (0)
#define WSP(T, off) ((T*)(a.ws() + (off)))
    PG8_LAS unsigned char* ldsl = (PG8_LAS unsigned char*)lds;

    { TIDS(); phase0(a, lds, gw, NGW, lane, wave); }
    GBAR();
    { pg8::Gemm g{WSP(const bf16_t, WS_CACT), WSP(const bf16_t, WS_ADA), D, D, 1024}; ModSplitOrder S{G, bx};
      EpiMod E{WSP(float, WS_MOD), a.in(I_BADA), a.in(I_BADAF)}; pg8::gemm_phase(ldsl, g, S, E); }
    { TIDS(); unsigned* fl = WSP(unsigned, WS_CTL) + 3648;
      if (bx < 176 && (bx % 88) < 16) { asm volatile("s_waitcnt vmcnt(0)" ::: "memory"); __syncthreads();
          if (tid == 0) { __builtin_amdgcn_fence(__ATOMIC_RELEASE, "agent"); asm volatile("s_waitcnt vmcnt(0)" ::: "memory"); __hip_atomic_fetch_add(fl, 1u, __ATOMIC_RELAXED, __HIP_MEMORY_SCOPE_AGENT); } }
      if (tid == 0) { unsigned sp = 0; while (__hip_atomic_load(fl, __ATOMIC_RELAXED, __HIP_MEMORY_SCOPE_AGENT) < 32u) { __builtin_amdgcn_s_sleep(4); if (++sp > (1u << 22)) break; } }
      __syncthreads(); }
    { TIDS(); norm1_prompt(a.in(I_XP), a.in(I_GF1), WSP(const float, WS_MOD), 0 * D, 1 * D, WSP(bf16_t, WS_H), gw, NGW, lane);
      norm_phase<false>(a.in(I_XP), a.in(I_XS), nullptr, 0, nullptr, a.in(I_GF1), WSP(const float, WS_MOD), 0 * D, 1 * D, WSP(bf16_t, WS_H), nullptr, nullptr, gw, NGW, lane, TP); }
    GBAR();
    { pg8::Gemm g{WSP(const bf16_t, WS_H), WSP(const bf16_t, WS_WUP1), D, D, D}; pg8::StaticOrder S; S.init(MP / 256, 2 * FF / 256, G, bx); EpiSwiGLU E{WSP(bf16_t, WS_BIG)}; pg8::gemm_phase(ldsl, g, S, E); }
    { TIDS(); convert_in_tail(a, lds, 1, (MP / 256) * (2 * FF / 256), bx, G, lane, wave); }
    GBAR();
    { pg8::Gemm g{WSP(const bf16_t, WS_BIG), WSP(const bf16_t, WS_WDN1), FF, FF, FF}; pg8::StaticOrder S; S.init(TP / 256, D / 256, G, bx);
      EpiResNorm<false> E{a.in(I_XP), WSP(float, WS_X), WSP(const float, WS_MOD), 2 * D, 0.5f, a.in(I_GMIX), 3 * D, 4 * D, WSP(bf16_t, WS_H), nullptr, WSP(float, WS_RS), WSP(unsigned, WS_RS + 32768)}; pg8::gemm_phase(ldsl, g, S, E); }
    { pg8::Gemm g{WSP(const bf16_t, WS_BIG), WSP(const bf16_t, WS_WDN1), FF, FF, KSPL}; SampleSplitOrder S; S.init(FF / KSPL, KSPL, G, bx);
      EpiPart E{WSP(float, WS_PART), WSP(const float, WS_MOD) + 2 * D, 0.5f, KSPL}; pg8::gemm_phase(ldsl, g, S, E); }
    GBAR();
#define SAMPLE_NORM_THEN_FLAG(FLAGW, ...) do { if (bx >= 240) { TIDS(); norm_phase<false>(__VA_ARGS__, (bx - 240) * 8 + wave, 128, lane, TP); \
        asm volatile("s_waitcnt vmcnt(0)" ::: "memory"); __syncthreads(); \
        if (tid == 0) { __builtin_amdgcn_fence(__ATOMIC_RELEASE, "agent"); asm volatile("s_waitcnt vmcnt(0)" ::: "memory"); __hip_atomic_fetch_add(WSP(unsigned, WS_CTL) + (FLAGW), 1u, __ATOMIC_RELAXED, __HIP_MEMORY_SCOPE_AGENT); } } } while (0)
    SAMPLE_NORM_THEN_FLAG(3520, WSP(const float, WS_X), a.in(I_XS), WSP(const float, WS_PART), FF / KSPL, WSP(float, WS_X), a.in(I_GMIX), WSP(const float, WS_MOD), 3 * D, 4 * D, WSP(bf16_t, WS_H), nullptr, nullptr);
    { pg8::Gemm g{WSP(const bf16_t, WS_H), WSP(const bf16_t, WS_WIN), D, D, D}; pg8::StaticOrder S; S.init(MP / 256, INCP / 256, G, bx, WSP(unsigned, WS_CTL) + 3520, 16u);
      EpiProj E{WSP(float, WS_BIG), WSP(bf16_t, WS_GLB), WSP(bf16_t, WS_ZB)}; pg8::gemm_phase(ldsl, g, S, E); }
    { TIDS(); convert_in_tail(a, lds, 2, (MP / 256) * (INCP / 256), bx, G, lane, wave); }
    GBAR();
    { TIDS();
#define M1_SAMPLE_SSD() do { for (int it = gw; it < NS * NH; it += NGW) ssd_sample(a, lds, it, lane, wave); __syncthreads(); } while (0)
    const int slot = bx & 3;
    if (slot == 0) M1_SAMPLE_SSD();
    for (int it = bx; it < NB * NCH * 4; it += G) ssd_pass1(a, lds, it, tid, lane, wave);
    if (slot == 1) M1_SAMPLE_SSD();
    lru_pass1_all(a, lds, bx, G, lane, wave);
    if (slot == 2) M1_SAMPLE_SSD();
    for (int it = bx; it < NS * NH / 8; it += G) lru_sample(a, lds, it, tid, lane, wave);
    if (slot == 3) M1_SAMPLE_SSD();
    conv_state_out(a, bx * 512 + tid, G * 512); }
    GBAR();
    { TIDS();
    for (int it = bx; it < NB * 4 * NH; it += G) ssd_pass2(a, lds, it, tid, lane, wave);
    for (int it = bx; it < NB * NCH * 8; it += G) lru_pass2(a, it, tid); }
    GBAR();
    { pg8::Gemm g{WSP(const bf16_t, WS_H), WSP(const bf16_t, WS_WOUT), D, D, D}; pg8::StaticOrder S; S.init(TP / 256, D / 256, G, bx);
      float* X = WSP(float, WS_X); EpiResNorm<false, true> E{X, X, WSP(const float, WS_MOD), 5 * D, 1.0f, a.in(I_GF2), 6 * D, 7 * D, WSP(bf16_t, WS_H), nullptr, WSP(float, WS_RS + 40960), WSP(unsigned, WS_RS + 40960 + 32768)}; pg8::gemm_phase(ldsl, g, S, E); }
    { pg8::Gemm g{WSP(const bf16_t, WS_H), WSP(const bf16_t, WS_WOUT), D, D, KSPL}; SampleSplitOrder S; S.init(D / KSPL, KSPL, G, bx);
      EpiPart E{WSP(float, WS_PART), WSP(const float, WS_MOD) + 5 * D, 1.0f, KSPL, 1}; pg8::gemm_phase(ldsl, g, S, E); }
    GBAR();
    SAMPLE_NORM_THEN_FLAG(3584, WSP(const float, WS_X), WSP(const float, WS_X) + (size_t)TP * D, WSP(const float, WS_PART), D / KSPL, WSP(float, WS_X), a.in(I_GF2), WSP(const float, WS_MOD), 6 * D, 7 * D, WSP(bf16_t, WS_H), nullptr, nullptr);
    { pg8::Gemm g{WSP(const bf16_t, WS_H), WSP(const bf16_t, WS_WUP2), D, D, D}; pg8::StaticOrder S; S.init(MP / 256, 2 * FF / 256, G, bx, WSP(unsigned, WS_CTL) + 3584, 16u); EpiSwiGLU E{WSP(bf16_t, WS_BIG)}; pg8::gemm_phase(ldsl, g, S, E); }
    GBAR();
    { pg8::Gemm g{WSP(const bf16_t, WS_BIG), WSP(const bf16_t, WS_WDN2), FF, FF, FF}; pg8::StaticOrder S; S.init(TP / 256, D / 256, G, bx);
      float* X = WSP(float, WS_X); EpiResNorm<true> E{X, X, WSP(const float, WS_MOD), 8 * D, 0.5f, a.in(I_GFIN), 9 * D, 10 * D, nullptr, a.out() + O_YP, WSP(float, WS_RS + 81920), WSP(unsigned, WS_RS + 81920 + 32768)}; pg8::gemm_phase(ldsl, g, S, E); }
    { pg8::Gemm g{WSP(const bf16_t, WS_BIG), WSP(const bf16_t, WS_WDN2), FF, FF, KSPL}; SampleSplitOrder S; S.init(FF / KSPL, KSPL, G, bx);
      EpiPart E{WSP(float, WS_PART), WSP(const float, WS_MOD) + 8 * D, 0.5f, KSPL}; pg8::gemm_phase(ldsl, g, S, E); }
    GBAR();
    { TIDS(); static_assert(FF / KSPL > 8 && FF / KSPL <= 24, "final_sample_norm sums partials k, k+8, k+16"); if (bx < NS) final_sample_norm(a, lds, bx, lane, wave); }
}

extern "C" void kernel_launch(void* const* d_in, const int* in_sizes, int n_in, void* d_out, int out_size, void* d_ws, size_t ws_size, hipStream_t stream) {
    static int grid = 0;
    if (grid == 0) {
        if (n_in != 35 || (size_t)out_size != O_END || ws_size < WS_END) { fprintf(stderr, "kernel_launch: unexpected shapes: n_in %d out %d ws %zu (need %zu)\n", n_in, out_size, ws_size, (size_t)WS_END); grid = -1; return; }
        int dev = 0, cus = 0, per_cu = 0;
        hipGetDevice(&dev); hipDeviceGetAttribute(&cus, hipDeviceAttributeMultiprocessorCount, dev);
        hipFuncSetAttribute((const void*)hymba_fwd, hipFuncAttributeMaxDynamicSharedMemorySize, LDS_BYTES);
        hipOccupancyMaxActiveBlocksPerMultiprocessor(&per_cu, (const void*)hymba_fwd, 512, LDS_BYTES);
        if (per_cu < 1) { fprintf(stderr, "kernel_launch: occupancy query says %d blocks/CU\n", per_cu); grid = -1; return; }
        if (cus != 256) { fprintf(stderr, "kernel_launch: built for a 256-CU device (fused norm epilogues need one 256x256 unit per workgroup), got %d CUs\n", cus); grid = -1; return; }
        grid = cus;
    }
    if (grid < 0) return;
    if (hipMemsetAsync((char*)d_ws + WS_CTL, 0, 16384, stream) != hipSuccess) { fprintf(stderr, "kernel_launch: memset of barrier words failed\n"); return; }
    Args a{};
    for (int i = 0; i < 35; ++i) a.in[i] = (const float*)d_in[i];
    a.out = (float*)d_out; a.ws = (unsigned char*)d_ws;
    void* args[] = {&a};
    hipError_t e = hipLaunchCooperativeKernel((const void*)hymba_fwd, dim3(grid), dim3(512), args, LDS_BYTES, stream);
    if (e != hipSuccess) fprintf(stderr, "cooperative launch failed: %s (grid %d)\n", hipGetErrorString(e), grid);
}
```

```cpp
#include <hip/hip_runtime.h>
#include <hip/hip_cooperative_groups.h>
#include <cstdio>
#include <cstdint>
namespace cg = cooperative_groups;

namespace pg8 {
#define PG8_LAS __attribute__((address_space(3)))
typedef unsigned short bf16_t;
typedef short bf16x8 __attribute__((ext_vector_type(8)));
typedef float f32x4 __attribute__((ext_vector_type(4)));
typedef unsigned u32x4 __attribute__((ext_vector_type(4)));
constexpr int BM = 256, BK = 64, HALF = 128, HTB = HALF * BK * 2, STAGE_BYTES = 8 * HTB, NXCD = 8, WGM = 8;

__host__ __device__ __forceinline__ int lds_byte(int r, int c) { const int st = (r >> 4) * 2 + (c >> 5), rr = r & 15, cc = c & 31, ob = rr * 64 + cc * 2; return st * 1024 + (ob ^ (((ob >> 9) & 1) << 5)); }
__host__ __device__ __forceinline__ void stage_rc(int b, int& R, int& C) { const int st = b / 1024, sb = b % 1024, swz = sb ^ (((sb >> 9) & 1) << 5); R = (st >> 1) * 16 + swz / 64; C = (st & 1) * 32 + (swz % 64) / 2; }
__host__ __device__ __forceinline__ int perm32(int rho) { const int n = rho >> 4, i = rho & 15; return 8 * (i >> 2) + 4 * n + (i & 3); }

struct Unit { int pm, pn, ko; };
struct Gemm { const bf16_t* A; const bf16_t* Bt; int lda, ldb, K; };

struct StaticOrder {
    int nM, nN, nwg, G, c; unsigned* flag; unsigned want;
    __device__ void init(int nM_, int nN_, int G_, int c_, unsigned* flag_ = nullptr, unsigned want_ = 0) { nM = nM_; nN = nN_; nwg = nM * nN; G = G_; c = c_; flag = flag_; want = want_; }
    __device__ __forceinline__ void a_ready(const Unit& u) const {
        if (flag && u.pm == 32) { unsigned sp = 0; while ((unsigned)__builtin_amdgcn_readfirstlane(__hip_atomic_load(flag, __ATOMIC_RELAXED, __HIP_MEMORY_SCOPE_AGENT)) < want) { __builtin_amdgcn_s_sleep(4); if (++sp > (1u << 22)) break; } asm volatile("s_waitcnt vmcnt(0)" ::: "memory"); }
    }
    __device__ bool next(int i, Unit& u) const {
        const long L = (long)i * G + c; if (L >= nwg) return false;
        int wgid = (int)L; { const int q = nwg / NXCD, r = nwg % NXCD, xcd = wgid % NXCD, off = wgid / NXCD; wgid = (xcd < r ? xcd * (q + 1) : r * (q + 1) + (xcd - r) * q) + off; }
        const int nig = WGM * nN, gid = wgid / nig, fm = gid * WGM, gsz = (nM - fm) < WGM ? (nM - fm) : WGM;
        u.pm = fm + ((wgid % nig) % gsz); u.pn = (wgid % nig) / gsz; u.ko = 0; return true;
    }
};

__device__ __forceinline__ unsigned cvt_pk_bf16(float lo, float hi) { unsigned r; asm volatile("v_cvt_pk_bf16_f32 %0, %1, %2" : "=v"(r) : "v"(lo), "v"(hi)); return r; }

template <class Epi, class Sched>
__device__ __forceinline__ void gemm_phase(PG8_LAS unsigned char* lds, const Gemm g, const Sched& S, const Epi& E) {
    int tid = threadIdx.x; asm volatile("" : "+v"(tid));
    const int wid = __builtin_amdgcn_readfirstlane(tid >> 6), lane = tid & 63, wr = wid >> 2, wc = wid & 3, fr = lane & 15, fq = lane >> 4;
    const int nt = g.K / BK;
    unsigned voffA[2], voffB[2];
#pragma unroll
    for (int i = 0; i < 2; ++i) { int R, C; stage_rc(tid * 16 + i * 8192, R, C); const int Rb = Epi::PERM ? ((R & ~31) + perm32(R & 31)) : R;
        voffA[i] = (unsigned)(R * g.lda + C) * 2u; voffB[i] = (unsigned)(Rb * g.ldb + C) * 2u; }
    const size_t kstep = (size_t)(BK * 2);
    const size_t hstepA = (size_t)HALF * g.lda * 2, hstepB = (size_t)HALF * g.ldb * 2;
    const size_t tstepA = 2 * hstepA, tstepB = 2 * hstepB;
    const unsigned ldsw = (unsigned)wid * 1024u;
    const int aoff = lds_byte(wr * 64 + fr, fq * 8), boff = lds_byte(wc * 32 + fr, fq * 8);
#define PG8_SA(b, h) (((b) * 2 + (h)) * HTB)
#define PG8_SB(b, h) ((4 + (b) * 2 + (h)) * HTB)
#define PG8_STAGE(bufoff, gbase, voff) do { _Pragma("unroll") for (int _i = 0; _i < 2; ++_i) \
        __builtin_amdgcn_global_load_lds((const unsigned*)((const char*)(gbase) + (voff)[_i]), (PG8_LAS unsigned*)(lds + (bufoff) + ldsw + _i * 8192), 16, 0, 0); } while (0)
#define PG8_LDA(dst, b, h) do { _Pragma("unroll") for (int m = 0; m < 4; ++m) _Pragma("unroll") for (int k = 0; k < 2; ++k) dst[m][k] = *(const PG8_LAS bf16x8*)(lds + PG8_SA(b, h) + aoff + m * 2048 + k * 1024); } while (0)
#define PG8_LDB(dst, b, h) do { _Pragma("unroll") for (int n = 0; n < 2; ++n) _Pragma("unroll") for (int k = 0; k < 2; ++k) dst[n][k] = *(const PG8_LAS bf16x8*)(lds + PG8_SB(b, h) + boff + n * 2048 + k * 1024); } while (0)
#define PG8_MMA(ai, bj, At, Bt) do { __builtin_amdgcn_s_setprio(1); _Pragma("unroll") for (int m = 0; m < 4; ++m) _Pragma("unroll") for (int n = 0; n < 2; ++n) _Pragma("unroll") for (int k = 0; k < 2; ++k) \
        acc[ai][bj][m][n] = __builtin_amdgcn_mfma_f32_16x16x32_bf16(Bt[n][k], At[m][k], acc[ai][bj][m][n], 0, 0, 0); __builtin_amdgcn_s_setprio(0); } while (0)
#define PG8_WAIT_V(n) asm volatile("s_waitcnt vmcnt(" #n ")" ::: "memory")
#define PG8_WAIT_L(n) asm volatile("s_waitcnt lgkmcnt(" #n ")" ::: "memory")
#define PG8_BAR __builtin_amdgcn_s_barrier()
#define PG8_SCHED __builtin_amdgcn_sched_barrier(0)
    Unit cur, nxt; int ui = 0;
    if (!S.next(0, cur)) return;
    f32x4 acc[2][2][4][2];
#pragma unroll
    for (int a = 0; a < 2; ++a)
#pragma unroll
        for (int b = 0; b < 2; ++b)
#pragma unroll
            for (int m = 0; m < 4; ++m)
#pragma unroll
                for (int n = 0; n < 2; ++n) acc[a][b][m][n] = (f32x4){0.f, 0.f, 0.f, 0.f};
    bf16x8 At[4][2], B0[2][2], B1[2][2];
    const char* cA = (const char*)g.A + (size_t)cur.pm * tstepA + (size_t)cur.ko * 2; const char* cB = (const char*)g.Bt + (size_t)cur.pn * tstepB + (size_t)cur.ko * 2;
    S.a_ready(cur);
    PG8_STAGE(PG8_SB(0, 0), cB, voffB); PG8_STAGE(PG8_SB(0, 1), cB + hstepB, voffB); PG8_STAGE(PG8_SA(0, 0), cA, voffA); PG8_STAGE(PG8_SA(0, 1), cA + hstepA, voffA);
    if (wr == 1) PG8_BAR;
    PG8_WAIT_V(2); PG8_BAR;
    PG8_STAGE(PG8_SB(1, 0), cB + kstep, voffB); PG8_STAGE(PG8_SA(1, 0), cA + kstep, voffA); PG8_STAGE(PG8_SB(1, 1), cB + hstepB + kstep, voffB);
    PG8_WAIT_V(6); PG8_BAR;
    for (;;) {
        const bool has_next = S.next(ui + 1, nxt);
        const char* nA = has_next ? (const char*)g.A + (size_t)nxt.pm * tstepA + (size_t)nxt.ko * 2 : cA; const char* nB = has_next ? (const char*)g.Bt + (size_t)nxt.pn * tstepB + (size_t)nxt.ko * 2 : cB;
        for (int t = 0; t < nt; t += 2) {
            const bool last = (t == nt - 2);
            if constexpr (Epi::MIDSCALE) { if (t == 16) E.midscale(acc, cur, wr, fr); }
            const char* a1 = cA + (size_t)(t + 1) * kstep;
            const char* a2 = last ? nA : cA + (size_t)(t + 2) * kstep; const char* b2 = last ? nB : cB + (size_t)(t + 2) * kstep;
            const char* a3 = a2 + kstep; const char* b3 = b2 + kstep;
            if (last && has_next) S.a_ready(nxt);
            PG8_LDB(B0, 0, 0); PG8_LDB(B1, 0, 1); PG8_SCHED; PG8_LDA(At, 0, 0); PG8_STAGE(PG8_SA(1, 1), a1 + hstepA, voffA);
            PG8_WAIT_V(8); PG8_WAIT_L(0); PG8_BAR; PG8_MMA(0, 0, At, B0); PG8_MMA(0, 1, At, B1); PG8_BAR; PG8_SCHED;
            PG8_LDA(At, 0, 1); PG8_STAGE(PG8_SB(0, 0), b2, voffB); PG8_STAGE(PG8_SB(0, 1), b2 + hstepB, voffB); PG8_STAGE(PG8_SA(0, 0), a2, voffA);
            PG8_WAIT_V(8); PG8_WAIT_L(0); PG8_BAR; PG8_MMA(1, 0, At, B0); PG8_MMA(1, 1, At, B1); PG8_BAR; PG8_SCHED;
            PG8_LDB(B0, 1, 0); PG8_LDB(B1, 1, 1); PG8_SCHED; PG8_LDA(At, 1, 0); PG8_STAGE(PG8_SA(0, 1), a2 + hstepA, voffA);
            PG8_WAIT_V(8); PG8_WAIT_L(0); PG8_BAR; PG8_MMA(0, 0, At, B0); PG8_MMA(0, 1, At, B1); PG8_BAR; PG8_SCHED;
            PG8_LDA(At, 1, 1); PG8_STAGE(PG8_SB(1, 0), b3, voffB); PG8_STAGE(PG8_SB(1, 1), b3 + hstepB, voffB); PG8_STAGE(PG8_SA(1, 0), a3, voffA);
            PG8_WAIT_V(8); PG8_WAIT_L(0); PG8_BAR; PG8_MMA(1, 0, At, B0); PG8_MMA(1, 1, At, B1); PG8_BAR; PG8_SCHED;
        }
        if (wr == 0) PG8_BAR;
        E(acc, cur, wr, wc, fr, fq);
        if (!has_next) break;
#pragma unroll
        for (int a = 0; a < 2; ++a)
#pragma unroll
            for (int b = 0; b < 2; ++b)
#pragma unroll
                for (int m = 0; m < 4; ++m)
#pragma unroll
                    for (int n = 0; n < 2; ++n) acc[a][b][m][n] = (f32x4){0.f, 0.f, 0.f, 0.f};
        cur = nxt; cA = nA; cB = nB; ++ui;
        if (wr == 1) PG8_BAR;
    }
    PG8_WAIT_V(0);
    PG8_BAR;
#undef PG8_SA
#undef PG8_SB
#undef PG8_STAGE
#undef PG8_LDA
#undef PG8_LDB
#undef PG8_MMA
#undef PG8_WAIT_V
#undef PG8_WAIT_L
#undef PG8_BAR
#undef PG8_SCHED
}
}

using pg8::bf16_t; using pg8::bf16x8; using pg8::f32x4; using pg8::u32x4;
typedef float f32x2 __attribute__((ext_vector_type(2)));
typedef unsigned u32x2 __attribute__((ext_vector_type(2)));

constexpr int D = 2048, TP = 8192, SEQ = 2048, NB = 4, NS = 128, MV = TP + NS  , MP = 8448  ;
constexpr int FF = 5632, WL = 1024, WS_ = 1024, NH = 16, HP = 64, NST = 128, CONVD = 1536, INC = 4624, INCP = 4864;
constexpr int NMOD = 22528;
constexpr float EPS = 1e-6f;
constexpr int NCH = 16;
constexpr int PC_XL = 0, PC_GL = 1024, PC_Z = 2048, PC_XBC = 3072, PC_DT = 4608;
constexpr size_t O_YP = 0, O_YS = 16777216, O_LHP = 17039360, O_LCP = 17043456, O_SSMP = 17055744, O_SCP = 17580032,
                 O_LHS = 17598464, O_LCS = 17729536, O_SSMS = 18122752, O_SCS = 34899968, O_END = 35489792;
constexpr size_t SZ_WUP = (size_t)2 * FF * D * 2, SZ_WDN = (size_t)D * FF * 2;
constexpr size_t WS_WUP1 = 0, WS_WDN1 = WS_WUP1 + SZ_WUP, WS_WUP2 = WS_WDN1 + SZ_WDN, WS_WDN2 = WS_WUP2 + SZ_WUP;
constexpr size_t WS_WIN = WS_WDN2 + SZ_WDN, WS_WOUT = WS_WIN + (size_t)INCP * D * 2, WS_WAT = WS_WOUT + (size_t)D * D * 2, WS_WIT = WS_WAT + 131072;
constexpr size_t WS_CACT = WS_WIT + 131072, WS_MOD = WS_CACT + (size_t)256 * D * 2, WS_H = WS_MOD + (size_t)2 * 256 * NMOD * 4;
constexpr size_t MODB = (size_t)256 * NMOD;
constexpr size_t WS_X = WS_H + (size_t)MP * D * 2, WS_BIG = WS_X + (size_t)MP * D * 4, WS_ADA = WS_BIG + (size_t)MP * INCP * 4;
constexpr size_t WS_ST = WS_ADA + (size_t)NMOD * D * 2, WS_SMALL = WS_ST + (size_t)NB * NCH * NH * HP * NST * 4;
constexpr size_t WS_CS = WS_SMALL, WS_SSQ = WS_CS + (size_t)MP * 16 * 4, WS_AGA = WS_SSQ + (size_t)MP * 16 * 4, WS_AGB = WS_AGA + 262144, WS_CD = WS_AGB + 262144, WS_CTL = WS_CD + 4096, WS_PART = WS_CTL + 16384, WS_RS = WS_PART + (size_t)22 * 128 * D * 4, WS_RSSQ = WS_RS + 3 * 40960, WS_END = WS_RSSQ + (size_t)MP * 4;
constexpr int KSPL = 256;
constexpr size_t WS_YPART = WS_WUP1;
constexpr size_t WS_GLB = WS_ADA + (size_t)MP * 1024 * 2, WS_ZB = WS_ADA + (size_t)MP * 1024 * 6;
constexpr size_t WS_ACUM = WS_ADA, WS_HLOC = WS_ACUM + (size_t)MP * 1024 * 4, WS_XS = WS_HLOC + (size_t)MP * 1024 * 4, WS_CACT2 = WS_XS + (size_t)MP * 1024 * 2;
static_assert(WS_CACT2 + (size_t)MP * 256 * 2 <= WS_ST, "ada region overlay");
static_assert((size_t)MP * FF * 2 <= (size_t)MP * INCP * 4, "act fits in big");

__device__ __forceinline__ unsigned pk2(float lo, float hi) { unsigned r; asm("v_cvt_pk_bf16_f32 %0, %1, %2" : "=v"(r) : "v"(lo), "v"(hi)); return r; }
__device__ __forceinline__ unsigned f2bf(float f) { return pk2(f, 0.f); }
__device__ __forceinline__ float bf2f(unsigned h) { return __builtin_bit_cast(float, h << 16); }
__device__ __forceinline__ float sigm(float x) { return __builtin_amdgcn_rcpf(1.f + __expf(-x)); }
__device__ __forceinline__ float siluf(float x) { return x * __builtin_amdgcn_rcpf(1.f + __expf(-x)); }
__device__ __forceinline__ float softplusf(float x) { return x > 20.f ? x : log1pf(expf(x)); }
__device__ __forceinline__ float gelu_tanh(float x) { const float u = 0.7978845608028654f * (x + 0.044715f * x * x * x); return 0.5f * x * (1.f + tanhf(u)); }
__device__ __forceinline__ float wave_sum(float v) {
#pragma unroll
    for (int o = 1; o < 64; o <<= 1) v += __shfl_xor(v, o);
    return v;
}
__device__ __forceinline__ int batch_row(int row) { return row < TP ? (row >> 11) : (NB + row - TP); }

struct EpiSwiGLU {
    static constexpr bool MIDSCALE = false;
    static constexpr bool PERM = true;
    bf16_t* O;
    __device__ __forceinline__ void operator()(f32x4 (&acc)[2][2][4][2], const pg8::Unit& u, int wr, int wc, int fr, int fq) const {
        const int row0 = u.pm * 256 + wr * 64 + fr, col0 = u.pn * 128 + wc * 32 + 8 * fq;
#pragma unroll
        for (int ai = 0; ai < 2; ++ai)
#pragma unroll
            for (int m = 0; m < 4; ++m) {
                bf16_t* rowp = O + (size_t)(row0 + ai * 128 + m * 16) * FF + col0;
                float o[8];
#pragma unroll
                for (int n = 0; n < 2; ++n)
#pragma unroll
                    for (int j = 0; j < 4; ++j) { const float gv = acc[ai][0][m][n][j], uv = acc[ai][1][m][n][j]; o[n * 4 + j] = gv * __builtin_amdgcn_rcpf(1.f + __expf(-gv)) * uv; }
                u32x4 w; w.x = pg8::cvt_pk_bf16(o[0], o[1]); w.y = pg8::cvt_pk_bf16(o[2], o[3]); w.z = pg8::cvt_pk_bf16(o[4], o[5]); w.w = pg8::cvt_pk_bf16(o[6], o[7]);
                *(u32x4*)rowp = w;
            }
    }
};
struct EpiRes {
    static constexpr bool MIDSCALE = false;
    static constexpr bool PERM = false;
    const float* base_p; const float* base_s; float* out; const float* gate; float s;
    __device__ __forceinline__ void operator()(f32x4 (&acc)[2][2][4][2], const pg8::Unit& u, int wr, int wc, int fr, int fq) const {
        const int col0 = u.pn * 256 + wc * 32 + 4 * fq;
#pragma unroll
        for (int ai = 0; ai < 2; ++ai)
#pragma unroll
            for (int m = 0; m < 4; ++m) {
                const int row = u.pm * 256 + ai * 128 + wr * 64 + m * 16 + fr;
                if (row < MV) {
                    const float* bp = row < TP ? base_p + (size_t)row * D : base_s + (size_t)(row - TP) * D;
                    const float* gp = gate + (size_t)batch_row(row) * NMOD;
                    float* op = out + (size_t)row * D;
#pragma unroll
                    for (int bj = 0; bj < 2; ++bj)
#pragma unroll
                        for (int n = 0; n < 2; ++n) { const int c = col0 + bj * 128 + n * 16;
                            const f32x4 b = *(const f32x4*)(bp + c), gg = *(const f32x4*)(gp + c) + *(const f32x4*)(gp + MODB + c);
                            *(f32x4*)(op + c) = b + (gg * s) * acc[ai][bj][m][n]; }
                }
            }
    }
};
struct EpiProj {
    static constexpr bool PERM = false, MIDSCALE = false, MTRIM = false;
    float* out; bf16_t* glb; bf16_t* zb;
    __device__ __forceinline__ void operator()(f32x4 (&acc)[2][2][4][2], const pg8::Unit& u, int wr, int wc, int fr, int fq) const {
        const int colt = wc * 32 + 4 * fq;
        if (u.pn >= 4 && u.pn < 12) {
            bf16_t* ob = (u.pn < 8 ? glb : zb) + (u.pn & 3) * 256 + colt;
#pragma unroll
            for (int ai = 0; ai < 2; ++ai)
#pragma unroll
                for (int m = 0; m < 4; ++m) { const int row = u.pm * 256 + ai * 128 + wr * 64 + m * 16 + fr;
                    if (row < MV) { bf16_t* op = ob + (size_t)row * 1024;
#pragma unroll
                        for (int bj = 0; bj < 2; ++bj)
#pragma unroll
                            for (int n = 0; n < 2; ++n) { const f32x4 v = acc[ai][bj][m][n]; u32x2 o; o.x = pk2(v.x, v.y); o.y = pk2(v.z, v.w); *(u32x2*)(op + bj * 128 + n * 16) = o; } } }
        } else {
            const int col0 = u.pn * 256 + colt;
#pragma unroll
            for (int ai = 0; ai < 2; ++ai)
#pragma unroll
                for (int m = 0; m < 4; ++m) { const int row = u.pm * 256 + ai * 128 + wr * 64 + m * 16 + fr;
                    if (row < MV) { float* op = out + (size_t)row * INCP + col0;
#pragma unroll
                        for (int bj = 0; bj < 2; ++bj)
#pragma unroll
                            for (int n = 0; n < 2; ++n) *(f32x4*)(op + bj * 128 + n * 16) = acc[ai][bj][m][n]; } }
        }
    }
};
struct EpiF32 {
    static constexpr bool MIDSCALE = false;
    static constexpr bool PERM = false;
    float* out; int ldc; int mvalid; const float* bias1; const float* bias2; int split;
    __device__ __forceinline__ void operator()(f32x4 (&acc)[2][2][4][2], const pg8::Unit& u, int wr, int wc, int fr, int fq) const {
        const int col0 = u.pn * 256 + wc * 32 + 4 * fq;
        f32x4 bv[2][2];
#pragma unroll
        for (int bj = 0; bj < 2; ++bj)
#pragma unroll
            for (int n = 0; n < 2; ++n) { const int c = col0 + bj * 128 + n * 16;
                bv[bj][n] = bias1 ? (c < split ? *(const f32x4*)(bias1 + c) : *(const f32x4*)(bias2 + (c - split))) : (f32x4){0.f, 0.f, 0.f, 0.f}; }
#pragma unroll
        for (int ai = 0; ai < 2; ++ai)
#pragma unroll
            for (int m = 0; m < 4; ++m) {
                const int row = u.pm * 256 + ai * 128 + wr * 64 + m * 16 + fr;
                if (row < mvalid) {
                    float* op = out + (size_t)row * ldc;
#pragma unroll
                    for (int bj = 0; bj < 2; ++bj)
#pragma unroll
                        for (int n = 0; n < 2; ++n) *(f32x4*)(op + col0 + bj * 128 + n * 16) = acc[ai][bj][m][n] + bv[bj][n];
                }
            }
    }
};

template <bool FINAL, bool MID = false>
struct EpiResNorm {
    static constexpr bool PERM = false, MIDSCALE = MID;
    __device__ __forceinline__ void midscale(f32x4 (&acc)[2][2][4][2], const pg8::Unit& u, int wr, int fr) const {
        asm volatile("" : "+v"(fr));
#pragma unroll
        for (int ai = 0; ai < 2; ++ai)
#pragma unroll
            for (int m = 0; m < 4; ++m) { const float* rssq = rs + (WS_RSSQ - (WS_RS + 40960)) / 4;
                const float r = rsqrtf(rssq[u.pm * 256 + ai * 128 + wr * 64 + m * 16 + fr] * (1.f / 1024.f) + EPS);
#pragma unroll
                for (int bj = 0; bj < 2; ++bj)
#pragma unroll
                    for (int n = 0; n < 2; ++n) acc[ai][bj][m][n] = acc[ai][bj][m][n] * r; }
    }
    const float* base; float* X; const float* mod; int g_off; float s; const float* gw; int sh_off, sc_off; bf16_t* H; float* out; float* rs; unsigned* cnt;
    __device__ __forceinline__ void operator()(f32x4 (&acc)[2][2][4][2], const pg8::Unit& u, int wr, int wc, int fr, int fq) const {
        const int col0 = u.pn * 256 + wc * 32 + 4 * fq, row0 = u.pm * 256 + wr * 64 + fr;
        const float* mr = mod + (size_t)(row0 >> 11) * NMOD;
#pragma unroll
        for (int bj = 0; bj < 2; ++bj)
#pragma unroll
            for (int n = 0; n < 2; ++n) { const int c = col0 + bj * 128 + n * 16;
                const f32x4 gg = (*(const f32x4*)(mr + g_off + c) + *(const f32x4*)(mr + MODB + g_off + c)) * s;
#pragma unroll
                for (int ai = 0; ai < 2; ++ai)
#pragma unroll
                    for (int m = 0; m < 4; ++m) { const size_t off = (size_t)(row0 + ai * 128 + m * 16) * D + c; acc[ai][bj][m][n] = *(const f32x4*)(base + off) + gg * acc[ai][bj][m][n]; }
                asm volatile("" : "+v"(acc[0][bj][0][n]), "+v"(acc[0][bj][1][n]), "+v"(acc[0][bj][2][n]), "+v"(acc[0][bj][3][n]), "+v"(acc[1][bj][0][n]), "+v"(acc[1][bj][1][n]), "+v"(acc[1][bj][2][n]), "+v"(acc[1][bj][3][n]) :: "memory"); }
#pragma unroll
        for (int ai = 0; ai < 2; ++ai)
#pragma unroll
            for (int m = 0; m < 4; ++m) { float q = 0.f;
#pragma unroll
                for (int bj = 0; bj < 2; ++bj)
#pragma unroll
                    for (int n = 0; n < 2; ++n) { const f32x4 v = acc[ai][bj][m][n]; q += (v.x * v.x + v.y * v.y) + (v.z * v.z + v.w * v.w); }
                q += __shfl_xor(q, 16); q += __shfl_xor(q, 32);
                if (fq == 0) __hip_atomic_fetch_add(rs + row0 + ai * 128 + m * 16, q, __ATOMIC_RELAXED, __HIP_MEMORY_SCOPE_AGENT); }
        asm volatile("s_waitcnt vmcnt(0)" ::: "memory");
        unsigned* pc = cnt + 64 * u.pm;
        if ((threadIdx.x & 63) == 0) __hip_atomic_fetch_add(pc, 1u, __ATOMIC_RELAXED, __HIP_MEMORY_SCOPE_AGENT);
        { unsigned sp = 0; while ((unsigned)__builtin_amdgcn_readfirstlane(__hip_atomic_load(pc, __ATOMIC_RELAXED, __HIP_MEMORY_SCOPE_AGENT)) < 64u) { __builtin_amdgcn_s_sleep(2); if (++sp > (1u << 20)) break; } }
        asm volatile("s_waitcnt vmcnt(0)" ::: "memory");
        float rstd[2][4];
#pragma unroll
        for (int ai = 0; ai < 2; ++ai)
#pragma unroll
            for (int m = 0; m < 4; ++m) rstd[ai][m] = rsqrtf(__hip_atomic_load(rs + row0 + ai * 128 + m * 16, __ATOMIC_RELAXED, __HIP_MEMORY_SCOPE_AGENT) * (1.f / D) + EPS);
#pragma unroll
        for (int bj = 0; bj < 2; ++bj)
#pragma unroll
            for (int n = 0; n < 2; ++n) { const int c = col0 + bj * 128 + n * 16;
                const f32x4 gg = *(const f32x4*)(gw + c), sc1 = (*(const f32x4*)(mr + sc_off + c) + *(const f32x4*)(mr + MODB + sc_off + c)) + 1.f, sh = *(const f32x4*)(mr + sh_off + c) + *(const f32x4*)(mr + MODB + sh_off + c);
                const f32x4 gs = gg * sc1;
#pragma unroll
                for (int ai = 0; ai < 2; ++ai)
#pragma unroll
                    for (int m = 0; m < 4; ++m) { const size_t off = (size_t)(row0 + ai * 128 + m * 16) * D + c;
                        const f32x4 xv = acc[ai][bj][m][n];
                        const f32x4 y = (xv * rstd[ai][m]) * gs + sh;
                        if (FINAL) *(f32x4*)(out + off) = y;
                        else { *(f32x4*)(X + off) = xv; u32x2 o; o.x = pk2(y.x, y.y); o.y = pk2(y.z, y.w); *(u32x2*)(H + off) = o; } }
                asm volatile("" ::: "memory"); }
    }
};
struct ModSplitOrder {
    int G, c;
    __device__ __forceinline__ void a_ready(const pg8::Unit&) const {}
    __device__ bool next(int i, pg8::Unit& u) const { const int j = i * G + c; if (j >= 176) return false; u.pm = 0; u.pn = j % 88; u.ko = (j / 88) * 1024; return true; }
};
struct EpiMod {
    static constexpr bool MIDSCALE = false;
    static constexpr bool PERM = false;
    float* out; const float* bias1; const float* bias2;
    __device__ __forceinline__ void operator()(f32x4 (&acc)[2][2][4][2], const pg8::Unit& u, int wr, int wc, int fr, int fq) const {
        const int col0 = u.pn * 256 + wc * 32 + 4 * fq; float* ob = out + (u.ko ? MODB : 0);
        f32x4 bv[2][2];
#pragma unroll
        for (int bj = 0; bj < 2; ++bj)
#pragma unroll
            for (int n = 0; n < 2; ++n) { const int c = col0 + bj * 128 + n * 16;
                bv[bj][n] = u.ko == 0 ? (c < 18432 ? *(const f32x4*)(bias1 + c) : *(const f32x4*)(bias2 + (c - 18432))) : (f32x4){0.f, 0.f, 0.f, 0.f}; }
#pragma unroll
        for (int ai = 0; ai < 2; ++ai)
#pragma unroll
            for (int m = 0; m < 4; ++m) {
                const int row = ai * 128 + wr * 64 + m * 16 + fr;
                if (row < NB + NS) { float* op = ob + (size_t)row * NMOD;
#pragma unroll
                    for (int bj = 0; bj < 2; ++bj)
#pragma unroll
                        for (int n = 0; n < 2; ++n) *(f32x4*)(op + col0 + bj * 128 + n * 16) = acc[ai][bj][m][n] + bv[bj][n]; }
            }
    }
};
struct SampleSplitOrder {
    int n, G, c, KS;
    __device__ __forceinline__ void a_ready(const pg8::Unit&) const {}
    __device__ void init(int nsplit, int KS_, int G_, int c_) { n = 8 * nsplit; G = G_; c = c_; KS = KS_; }
    __device__ bool next(int i, pg8::Unit& u) const { const int j = i * G + c; if (j >= n) return false; u.pm = 32; u.pn = j & 7; u.ko = (j >> 3) * KS; return true; }
};
struct EpiPart {
    static constexpr bool MIDSCALE = false;
    static constexpr bool PERM = false;
    float* part; const float* gate; float s; int KS; int ssd_scale = 0;
    __device__ __forceinline__ void operator()(f32x4 (&acc)[2][2][4][2], const pg8::Unit& u, int wr, int wc, int fr, int fq) const {
        const int col0 = u.pn * 256 + wc * 32 + 4 * fq, ks = u.ko / KS;
#pragma unroll
        for (int m = 0; m < 4; ++m) {
            const int rl = wr * 64 + m * 16 + fr;
            const float* gp = gate + (size_t)(NB + rl) * NMOD; float* op = part + ((size_t)ks * 128 + rl) * D;
            const float sr = (ssd_scale && u.ko < 1024) ? s * rsqrtf((part + (WS_RSSQ - WS_PART) / 4)[TP + rl] * (1.f / 1024.f) + EPS) : s;
#pragma unroll
            for (int bj = 0; bj < 2; ++bj)
#pragma unroll
                for (int n = 0; n < 2; ++n) { const int c = col0 + bj * 128 + n * 16; const f32x4 gg = *(const f32x4*)(gp + c) + *(const f32x4*)(gp + MODB + c); *(f32x4*)(op + c) = (gg * sr) * acc[0][bj][m][n]; }
        }
    }
};

struct Args { const float* in[35]; float* out; unsigned char* ws; int never; int pad; };
constexpr int ARGTAB_OFF = 131072 + 1024;
struct AP {
    const unsigned* tab;
    __device__ __forceinline__ unsigned long long raw(int i) const { const unsigned lo = __builtin_amdgcn_readfirstlane(tab[2 * i]), hi = __builtin_amdgcn_readfirstlane(tab[2 * i + 1]); return ((unsigned long long)hi << 32) | lo; }
    __device__ __forceinline__ const float* in(int i) const { return (const float*)raw(i); }
    __device__ __forceinline__ float* out() const { return (float*)raw(35); }
    __device__ __forceinline__ unsigned char* ws() const { return (unsigned char*)raw(36); }
};
enum { I_XP = 0, I_XS, I_CP, I_CS, I_SLH, I_SLC, I_SSM, I_SSC, I_WADA, I_BADA, I_GF1, I_WUP1, I_WDN1, I_GMIX, I_WIN, I_LCW, I_LCB, I_LWA, I_LBA, I_LWI, I_LBI,
       I_LLAM, I_SCW, I_SCB, I_DTB, I_ALOG, I_SD, I_SNG, I_WOUT, I_GF2, I_WUP2, I_WDN2, I_WADAF, I_BADAF, I_GFIN };

__device__ __forceinline__ void p0_item(const float* W, int K, int N, bf16_t* WT, int k0, int n0, int drow0, float* scr, int lane, int kdst = -1) {
    if (kdst < 0) kdst = k0;
    const int nn = n0 + (lane & 31); const bool ok = nn < N;
    float rv[32];
    const float* wp = W + (size_t)(k0 + (lane >> 5)) * N + (ok ? nn : 0);
#pragma unroll
    for (int i = 0; i < 32; ++i) rv[i] = __builtin_nontemporal_load(wp + (size_t)(2 * i) * N);
#pragma unroll
    for (int i = 0; i < 32; ++i) { const int kk = 2 * i + (lane >> 5); scr[kk * 33 + (lane & 31)] = ok ? rv[i] : 0.f; }
    asm volatile("s_waitcnt lgkmcnt(0)" ::: "memory");
    const int c = lane & 7;
#pragma unroll
    for (int j = 0; j < 4; ++j) { const int n = (lane >> 3) + 8 * j; const float* s = scr + (8 * c) * 33 + n;
        u32x4 o; o.x = pk2(s[0 * 33], s[1 * 33]); o.y = pk2(s[2 * 33], s[3 * 33]); o.z = pk2(s[4 * 33], s[5 * 33]); o.w = pk2(s[6 * 33], s[7 * 33]);
        if (n0 + n < N) *(u32x4*)(WT + (size_t)(drow0 + n) * K + kdst + 8 * c) = o; }
    asm volatile("s_waitcnt lgkmcnt(0)" ::: "memory");
}
__device__ __forceinline__ int up_row(int n0) { return n0 < FF ? (n0 >> 7) * 256 + (n0 & 127) : ((n0 - FF) >> 7) * 256 + 128 + ((n0 - FF) & 127); }

__device__ __forceinline__ void convert_part(const AP& a, unsigned char* lds, int part, int worker, int nworkers, int lane, int wave) {
    float* scr = (float*)(lds + wave * 16384);
    unsigned char* ws = a.ws();
    constexpr int I_UP = (D / 64) * (2 * FF / 32), I_DN = (FF / 64) * (D / 32), I_IN = (D / 64) * 145, I_OUT = (D / 64) * (D / 32),
                  I_ADA = (D / 64) * (18432 / 32), I_ADAF = (D / 64) * (4096 / 32), I_G = 32, I_UPQ = I_UP / 4;
    if (part == 0) {
        constexpr int NIT = I_ADA + I_ADAF + (I_UP - I_UPQ) + 2 * I_G;
        for (int it = worker; it < NIT; it += nworkers) {
            int r = it;
            if (r < I_ADA) { const int kb = r / 576, nb = r % 576; p0_item(a.in(I_WADA), D, 18432, (bf16_t*)(ws + WS_ADA), kb * 64, nb * 32, nb * 32, scr, lane); continue; }
            r -= I_ADA;
            if (r < I_ADAF) { const int kb = r / 128, nb = r % 128; p0_item(a.in(I_WADAF), D, 4096, (bf16_t*)(ws + WS_ADA), kb * 64, nb * 32, 18432 + nb * 32, scr, lane); continue; }
            r -= I_ADAF;
            if (r < I_UP - I_UPQ) { r += I_UPQ; const int nblk = 2 * FF / 32, kb = r / nblk, nb = r % nblk; p0_item(a.in(I_WUP1), D, 2 * FF, (bf16_t*)(ws + WS_WUP1), kb * 64, nb * 32, up_row(nb * 32), scr, lane); continue; }
            r -= I_UP - I_UPQ;
            { const int w = r >= I_G; r -= w * I_G; const int h = r >> 1, nb = r & 1;
              p0_item(a.in(w ? I_LWI : I_LWA) + h * 4096, 64, 64, (bf16_t*)(ws + (w ? WS_WIT : WS_WAT)) + h * 4096, 0, nb * 32, nb * 32, scr, lane); }
        }
    } else if (part == 3) {
        for (int r = worker; r < I_UPQ; r += nworkers) { const int nblk = 2 * FF / 32, kb = r / nblk, nb = r % nblk; p0_item(a.in(I_WUP1), D, 2 * FF, (bf16_t*)(ws + WS_WUP1), kb * 64, nb * 32, up_row(nb * 32), scr, lane); }
    } else if (part == 1) {
        constexpr int NIT = I_DN + I_IN + I_OUT;
        for (int it = worker; it < NIT; it += nworkers) {
            int r = it;
            if (r < I_DN) { const int nblk = D / 32, kb = r / nblk, nb = r % nblk; p0_item(a.in(I_WDN1), FF, D, (bf16_t*)(ws + WS_WDN1), kb * 64, nb * 32, nb * 32, scr, lane); continue; }
            r -= I_DN;
            if (r < I_IN) { const int kb = r / 145, nb = r % 145; p0_item(a.in(I_WIN), D, INC, (bf16_t*)(ws + WS_WIN), kb * 64, nb * 32, nb * 32, scr, lane); continue; }
            r -= I_IN;
            { const int kb = r / 64, nb = r % 64; p0_item(a.in(I_WOUT), D, D, (bf16_t*)(ws + WS_WOUT), kb * 64, nb * 32, nb * 32, scr, lane, (kb * 64 + 1024) & 2047); }
        }
    } else {
        constexpr int NIT = I_UP + I_DN;
        for (int it = worker; it < NIT; it += nworkers) {
            int r = it;
            if (r < I_UP) { const int nblk = 2 * FF / 32, kb = r / nblk, nb = r % nblk; p0_item(a.in(I_WUP2), D, 2 * FF, (bf16_t*)(ws + WS_WUP2), kb * 64, nb * 32, up_row(nb * 32), scr, lane); continue; }
            r -= I_UP;
            { const int nblk = D / 32, kb = r / nblk, nb = r % nblk; p0_item(a.in(I_WDN2), FF, D, (bf16_t*)(ws + WS_WDN2), kb * 64, nb * 32, nb * 32, scr, lane); }
        }
    }
}
__device__ __forceinline__ void convert_in_tail(const AP& a, unsigned char* lds, int part, int nunits, int bx, int G, int lane, int wave) {
    const int lo = nunits % G;
    if (bx >= lo) convert_part(a, lds, part, (bx - lo) * 8 + wave, (G - lo) * 8, lane, wave);
}
__device__ __forceinline__ void phase0(const AP& a, unsigned char* lds, int gw, int NGW, int lane, int wave) {
    convert_part(a, lds, 0, gw, NGW, lane, wave);
    { unsigned* rsz = (unsigned*)(a.ws() + WS_RS); for (int i = gw * 64 + lane; i < 3 * 10240 + MP; i += NGW * 64) rsz[i] = 0u; }
    unsigned char* ws = a.ws();
    bf16_t* cact = (bf16_t*)(ws + WS_CACT);
    for (int e = gw * 64 + lane; e < (NB + NS) * D / 4; e += NGW * 64) {
        const int row = e / (D / 4), c4 = e % (D / 4);
        const float* src = row < NB ? a.in(I_CP) + (size_t)row * D : a.in(I_CS) + (size_t)(row - NB) * D;
        const f32x4 v = *(const f32x4*)(src + c4 * 4);
        u32x2 o; o.x = pk2(siluf(v.x), siluf(v.y)); o.y = pk2(siluf(v.z), siluf(v.w));
        *(u32x2*)(cact + (size_t)row * D + c4 * 4) = o;
    }
}

template <bool FINAL>
__device__ __forceinline__ void norm_phase(const float* xp, const float* xs, const float* part, int nsplit, float* xw, const float* g, const float* mod, int sh_off, int sc_off, bf16_t* H, float* outp, float* outs, int gw, int NGW, int lane, int row_begin = 0) {
    for (int row = row_begin + gw; row < MV; row += NGW) {
        const float* src = row < TP ? xp + (size_t)row * D : xs + (size_t)(row - TP) * D;
        const float* mr = mod + (size_t)batch_row(row) * NMOD;
        f32x4 v[8]; float ss = 0.f;
#pragma unroll
        for (int j = 0; j < 8; ++j) v[j] = *(const f32x4*)(src + (64 * j + lane) * 4);
        if (row >= TP && nsplit > 0) {
            const float* pp = part + (size_t)(row - TP) * D + lane * 4;
            int k = 0;
#pragma unroll 1
            for (; k + 4 <= nsplit; k += 4) { f32x4 t[4][8];
#pragma unroll
                for (int u = 0; u < 4; ++u)
#pragma unroll
                    for (int j = 0; j < 8; ++j) t[u][j] = *(const f32x4*)(pp + (size_t)(k + u) * 128 * D + 256 * j);
#pragma unroll
                for (int u = 0; u < 4; ++u)
#pragma unroll
                    for (int j = 0; j < 8; ++j) v[j] += t[u][j]; }
#pragma unroll 1
            for (; k < nsplit; ++k) {
#pragma unroll
                for (int j = 0; j < 8; ++j) v[j] += *(const f32x4*)(pp + (size_t)k * 128 * D + 256 * j); }
            if (xw) {
#pragma unroll
                for (int j = 0; j < 8; ++j) *(f32x4*)(xw + (size_t)row * D + (64 * j + lane) * 4) = v[j]; }
        }
#pragma unroll
        for (int j = 0; j < 8; ++j) ss += (v[j].x * v[j].x + v[j].y * v[j].y) + (v[j].z * v[j].z + v[j].w * v[j].w);
        const float rstd = rsqrtf(wave_sum(ss) * (1.f / D) + EPS);
#pragma unroll
        for (int j = 0; j < 8; ++j) { const int c = (64 * j + lane) * 4;
            const f32x4 gg = *(const f32x4*)(g + c), sc = *(const f32x4*)(mr + sc_off + c) + *(const f32x4*)(mr + MODB + sc_off + c), sh = *(const f32x4*)(mr + sh_off + c) + *(const f32x4*)(mr + MODB + sh_off + c);
            const f32x4 y = (v[j] * rstd * gg) * (sc + 1.f) + sh;
            if (FINAL) { float* o = row < TP ? outp + (size_t)row * D : outs + (size_t)(row - TP) * D; *(f32x4*)(o + c) = y; }
            else { u32x2 o; o.x = pk2(y.x, y.y); o.y = pk2(y.z, y.w); *(u32x2*)(H + (size_t)row * D + c) = o; } }
    }
}


__device__ __forceinline__ void norm1_prompt(const float* xp, const float* g, const float* mod, int sh_off, int sc_off, bf16_t* H, int gw, int NGW, int lane) {
#pragma unroll 1
    for (int r0 = gw * 4; r0 < TP; r0 += NGW * 4) {
        const float* mr = mod + (size_t)(r0 >> 11) * NMOD;
        f32x4 va[2][8], vb[2][8];
#pragma unroll
        for (int r = 0; r < 2; ++r)
#pragma unroll
            for (int j = 0; j < 8; ++j) va[r][j] = *(const f32x4*)(xp + (size_t)(r0 + r) * D + (64 * j + lane) * 4);
        asm volatile("" ::: "memory");
        f32x4 gs[8], sh[8];
#pragma unroll
        for (int j = 0; j < 8; ++j) { const int c = (64 * j + lane) * 4;
            gs[j] = *(const f32x4*)(g + c) * ((*(const f32x4*)(mr + sc_off + c) + *(const f32x4*)(mr + MODB + sc_off + c)) + 1.f);
            sh[j] = *(const f32x4*)(mr + sh_off + c) + *(const f32x4*)(mr + MODB + sh_off + c);
            if (j & 1) asm volatile("" ::: "memory"); }
#pragma unroll
        for (int r = 0; r < 2; ++r)
#pragma unroll
            for (int j = 0; j < 8; ++j) vb[r][j] = *(const f32x4*)(xp + (size_t)(r0 + 2 + r) * D + (64 * j + lane) * 4);
#define NORM1_ROWS(V, RB) do { _Pragma("unroll") for (int r = 0; r < 2; ++r) { float ss = 0.f; \
            _Pragma("unroll") for (int j = 0; j < 8; ++j) { const f32x4 v = V[r][j]; ss += (v.x * v.x + v.y * v.y) + (v.z * v.z + v.w * v.w); } \
            const float rstd = rsqrtf(wave_sum(ss) * (1.f / D) + EPS); \
            _Pragma("unroll") for (int j = 0; j < 8; ++j) { const f32x4 y = (V[r][j] * rstd) * gs[j] + sh[j]; \
                u32x2 o; o.x = pk2(y.x, y.y); o.y = pk2(y.z, y.w); *(u32x2*)(H + (size_t)(r0 + (RB) + r) * D + (64 * j + lane) * 4) = o; } } } while (0)
        NORM1_ROWS(va, 0);
        NORM1_ROWS(vb, 2);
#undef NORM1_ROWS
    }
}


__device__ __forceinline__ void final_sample_norm(const AP& a, unsigned char* lds, int rl, int lane, int wave) {
    unsigned char* ws = a.ws();
    const float* part = (const float*)(ws + WS_PART) + (size_t)rl * D + lane * 4;
    const float* xrow = (const float*)(ws + WS_X) + (size_t)(TP + rl) * D + lane * 4;
    constexpr int NSP = FF / KSPL;
    f32x4 v[8], t0[8], t1[8], t2[8];
#pragma unroll
    for (int j = 0; j < 8; ++j) { t0[j] = *(const f32x4*)(part + (size_t)wave * 128 * D + 256 * j);
        t1[j] = *(const f32x4*)(part + (size_t)(wave + 8) * 128 * D + 256 * j);
        t2[j] = (wave + 16 < NSP) ? *(const f32x4*)(part + (size_t)(wave + 16) * 128 * D + 256 * j) : (f32x4){0.f, 0.f, 0.f, 0.f};
        v[j] = (wave == 0) ? *(const f32x4*)(xrow + 256 * j) : (f32x4){0.f, 0.f, 0.f, 0.f}; }
    float* s_red = (float*)lds;
    float* s_ss = s_red + 8 * D;
#pragma unroll
    for (int j = 0; j < 8; ++j) *(f32x4*)(s_red + wave * D + 256 * j + lane * 4) = (v[j] + t0[j]) + (t1[j] + t2[j]);
    __syncthreads();
    const int c = wave * 256 + lane * 4;
    f32x4 x = *(const f32x4*)(s_red + c);
#pragma unroll
    for (int w = 1; w < 8; ++w) x += *(const f32x4*)(s_red + w * D + c);
    const float ss = wave_sum((x.x * x.x + x.y * x.y) + (x.z * x.z + x.w * x.w));
    if (lane == 0) s_ss[wave] = ss;
    const float* mr = (const float*)(ws + WS_MOD) + (size_t)(NB + rl) * NMOD;
    const f32x4 gg = *(const f32x4*)(a.in(I_GFIN) + c), sc = *(const f32x4*)(mr + 10 * D + c) + *(const f32x4*)(mr + MODB + 10 * D + c), sh = *(const f32x4*)(mr + 9 * D + c) + *(const f32x4*)(mr + MODB + 9 * D + c);
    __syncthreads();
    float tot = 0.f;
#pragma unroll
    for (int w = 0; w < 8; ++w) tot += s_ss[w];
    const float rstd = rsqrtf(tot * (1.f / D) + EPS);
    *(f32x4*)(a.out() + O_YS + (size_t)rl * D + c) = (x * rstd * gg) * (sc + 1.f) + sh;
}

constexpr int LD = 136;
__device__ __forceinline__ f32x4 mfma16(bf16x8 a, bf16x8 b, f32x4 c) { return __builtin_amdgcn_mfma_f32_16x16x32_bf16(a, b, c, 0, 0, 0); }

__device__ __forceinline__ void ssd_pass1(const AP& a, unsigned char* lds, int item, int tid, int lane, int wave) {
    const int hh = item & 1, g = (item >> 1) & 1, c = (item >> 2) & 15, b = item >> 6, h0 = g * 8 + hh * 4;
    const int row0 = b * SEQ + c * 128;
    unsigned char* ws = a.ws();
    const float* proj = (const float*)(ws + WS_BIG);
    bf16_t* sC = (bf16_t*)lds; bf16_t* sB = (bf16_t*)(lds + 34816); bf16_t* sBT = (bf16_t*)(lds + 69632);
    bf16_t* sXT = (bf16_t*)(lds + 34816); bf16_t* sXdT = (bf16_t*)(lds + 52224);
    float* s_cs = (float*)(lds + 104448); float* s_dt = s_cs + 512; float* s_da = s_dt + 512;
    const int l0 = wave * 16, fr = lane & 15, fq = lane >> 4;
    {
        const int hl = tid >> 7, l = tid & 127, h = h0 + hl;
        const float Ah = -expf(a.in(I_ALOG)[h]);
        const float dt = softplusf(proj[(size_t)(row0 + l) * INCP + PC_DT + h] + a.in(I_DTB)[h]); s_dt[tid] = dt; s_da[tid] = dt * Ah;
    }
    {
        const float* cw = a.in(I_SCW); const float* cb = a.in(I_SCB); bf16_t* cact2 = (bf16_t*)(ws + WS_CACT2);
#pragma unroll
        for (int cg4 = 0; cg4 < 4; ++cg4) {
            const int n = (cg4 & 1) * 64 + lane;
            const int xcol = (cg4 < 2 ? 1024 : 1280) + g * 128 + n;
            const float w0 = cw[xcol], w1 = cw[CONVD + xcol], w2 = cw[2 * CONVD + xcol], w3 = cw[3 * CONVD + xcol], bb = cb[xcol];
            const float* pcol = proj + PC_XBC + xcol;
            float pv[19];
#pragma unroll
            for (int i = 0; i < 19; ++i) { const int l = l0 - 3 + i; pv[i] = (c * 128 + l >= 0) ? pcol[(size_t)(row0 + l) * INCP] : 0.f; }
            unsigned pkv[8];
#pragma unroll
            for (int i = 0; i < 16; i += 2) {
                const float v0 = siluf(bb + w0 * pv[i] + w1 * pv[i + 1] + w2 * pv[i + 2] + w3 * pv[i + 3]), v1 = siluf(bb + w0 * pv[i + 1] + w1 * pv[i + 2] + w2 * pv[i + 3] + w3 * pv[i + 4]);
                pkv[i >> 1] = pk2(v0, v1);
            }
#pragma unroll
            for (int i = 0; i < 16; ++i) {
                const int l = l0 + i; const bf16_t v = (bf16_t)((i & 1) ? (pkv[i >> 1] >> 16) : pkv[i >> 1]);
                if (cg4 < 2) sB[l * LD + n] = v;
                else { sC[l * LD + n] = v; if (hh == 0) cact2[(size_t)(row0 + l) * 256 + g * 128 + n] = v; }
            }
            if (cg4 < 2) { *(u32x4*)(sBT + n * LD + l0) = (u32x4){pkv[0], pkv[1], pkv[2], pkv[3]}; *(u32x4*)(sBT + n * LD + l0 + 8) = (u32x4){pkv[4], pkv[5], pkv[6], pkv[7]}; }
        }
    }
    __syncthreads();
    {
        const int hl = tid >> 7, l = tid & 127; float v = s_da[tid];
#pragma unroll
        for (int o = 1; o < 64; o <<= 1) { const float t = __shfl_up(v, o); v += (lane >= o) ? t : 0.f; }
        if (l >= 64) v += wave_sum(s_da[hl * 128 + lane]);
        s_cs[tid] = v; ((float*)(ws + WS_CS))[(size_t)(row0 + l) * 16 + h0 + hl] = v;
        if (l == 127) ((float*)(ws + WS_CD))[(b * NCH + c) * 16 + h0 + hl] = __expf(v);
    }
    const int stmax = wave | 1, kmax = (wave * 16 + 15) >> 5;
    f32x4 cbv[8];
    {
        bf16x8 af[4];
#pragma unroll
        for (int kk = 0; kk < 4; ++kk) af[kk] = *(const bf16x8*)(sC + (l0 + fr) * LD + kk * 32 + fq * 8);
#pragma unroll
        for (int st = 0; st < 8; ++st) {
            cbv[st] = (f32x4){0.f, 0.f, 0.f, 0.f};
            if (st <= stmax) {
#pragma unroll
                for (int kk = 0; kk < 4; ++kk) { const bf16x8 bfv = *(const bf16x8*)(sB + (st * 16 + fr) * LD + kk * 32 + fq * 8); cbv[st] = mfma16(af[kk], bfv, cbv[st]); }
            }
        }
    }
    __syncthreads();
    bf16_t* sM = sC;
    bf16_t* xs_g = (bf16_t*)(ws + WS_XS); float* ypart = (float*)(ws + WS_YPART);
    const float* cw = a.in(I_SCW); const float* cb = a.in(I_SCB);
    float pvn[19];
#define SSD_LOADX(hl_) do { const float* pc_ = proj + (size_t)(row0 + l0 - 3) * INCP + PC_XBC + (h0 + (hl_)) * 64 + lane; \
        _Pragma("unroll") for (int i = 0; i < 19; ++i) pvn[i] = (c * 128 + l0 - 3 + i >= 0) ? pc_[(size_t)i * INCP] : 0.f; } while (0)
    SSD_LOADX(0);
#pragma unroll 1
    for (int hl = 0; hl < 4; ++hl) {
        const int h = h0 + hl;
        const float* cs = s_cs + hl * 128; const float* dts = s_dt + hl * 128;
        const float cs_last = cs[127];
        {
            const int xcol = h * 64 + lane;
            const float w0 = cw[xcol], w1 = cw[CONVD + xcol], w2 = cw[2 * CONVD + xcol], w3 = cw[3 * CONVD + xcol], bb = cb[xcol];
            float pv[19];
#pragma unroll
            for (int i = 0; i < 19; ++i) pv[i] = pvn[i];
            if (hl < 3) SSD_LOADX(hl + 1);
            unsigned pkx[8], pkd[8];
#pragma unroll
            for (int i = 0; i < 16; i += 2) {
                const int l = l0 + i;
                const float v0 = siluf(bb + w0 * pv[i] + w1 * pv[i + 1] + w2 * pv[i + 2] + w3 * pv[i + 3]), v1 = siluf(bb + w0 * pv[i + 1] + w1 * pv[i + 2] + w2 * pv[i + 3] + w3 * pv[i + 4]);
                const float x0 = v0 * dts[l], x1 = v1 * dts[l + 1];
                pkx[i >> 1] = pk2(x0, x1); pkd[i >> 1] = pk2(x0 * __expf(cs_last - cs[l]), x1 * __expf(cs_last - cs[l + 1]));
                const unsigned pv2 = pk2(v0, v1);
                xs_g[(size_t)(row0 + l) * 1024 + xcol] = (bf16_t)pv2; xs_g[(size_t)(row0 + l + 1) * 1024 + xcol] = (bf16_t)(pv2 >> 16);
            }
            *(u32x4*)(sXT + lane * LD + l0) = (u32x4){pkx[0], pkx[1], pkx[2], pkx[3]}; *(u32x4*)(sXT + lane * LD + l0 + 8) = (u32x4){pkx[4], pkx[5], pkx[6], pkx[7]};
            *(u32x4*)(sXdT + lane * LD + l0) = (u32x4){pkd[0], pkd[1], pkd[2], pkd[3]}; *(u32x4*)(sXdT + lane * LD + l0 + 8) = (u32x4){pkd[4], pkd[5], pkd[6], pkd[7]};
        }
#pragma unroll
        for (int st = 0; st < 8; ++st) {
            if (st <= stmax) {
                const int sidx = st * 16 + fr; const float css = cs[sidx];
#pragma unroll
                for (int i = 0; i < 4; ++i) { const int l = l0 + fq * 4 + i;
                    const float mv = (sidx <= l) ? cbv[st][i] * __expf(cs[l] - css) : 0.f;
                    sM[l * LD + sidx] = (bf16_t)f2bf(mv); }
            }
        }
        __syncthreads();
#pragma unroll
        for (int pt = 0; pt < 4; ++pt) {
            f32x4 y = (f32x4){0.f, 0.f, 0.f, 0.f};
#pragma unroll
            for (int kk = 0; kk < 4; ++kk) if (kk <= kmax) {
                const bf16x8 am = *(const bf16x8*)(sM + (l0 + fr) * LD + kk * 32 + fq * 8);
                const bf16x8 bx = *(const bf16x8*)(sXT + (pt * 16 + fr) * LD + kk * 32 + fq * 8);
                y = mfma16(am, bx, y); }
#pragma unroll
            for (int i = 0; i < 4; ++i) ypart[(size_t)(row0 + l0 + fq * 4 + i) * 1024 + h * 64 + pt * 16 + fr] = y[i];
        }
        float* st_g = (float*)(ws + WS_ST) + (size_t)((b * NCH + c) * NH + h) * (HP * NST);
#pragma unroll
        for (int pt = 0; pt < 4; ++pt) {
            f32x4 sacc = (f32x4){0.f, 0.f, 0.f, 0.f};
#pragma unroll
            for (int kk = 0; kk < 4; ++kk) {
                const bf16x8 ax = *(const bf16x8*)(sXdT + (pt * 16 + fr) * LD + kk * 32 + fq * 8);
                const bf16x8 bb2 = *(const bf16x8*)(sBT + (wave * 16 + fr) * LD + kk * 32 + fq * 8);
                sacc = mfma16(ax, bb2, sacc); }
#pragma unroll
            for (int i = 0; i < 4; ++i) st_g[(pt * 16 + fq * 4 + i) * NST + wave * 16 + fr] = sacc[i];
        }
        __syncthreads();
    }
}

__device__ __forceinline__ void lru_pass1_all(const AP& a, unsigned char* lds, int bx, int G, int lane, int wave) {
    constexpr int NIT = NB * NCH * NH;
    if (bx >= NIT) return;
    unsigned char* ws = a.ws();
    const float* proj = (const float*)(ws + WS_BIG);
    float* s_xc = (float*)lds;
    bf16_t* s_xb = (bf16_t*)(lds + 33280);
    float* s_a = (float*)(lds + 51712);
    float* s_b = (float*)(lds + 84992);
    float* s_ag = (float*)(lds + 118272);
    bf16_t* acum = (bf16_t*)(ws + WS_ACUM); bf16_t* hloc = (bf16_t*)(ws + WS_HLOC);
    const int l0 = wave * 16, fr = lane & 15, fq = lane >> 4;
    int hcur = -1, par = 0;
    float w0 = 0.f, w1 = 0.f, w2 = 0.f, w3 = 0.f, bb = 0.f;
    float bav[4], biv[4], sp[4]; bf16x8 ba[4][2], bi[4][2];
    float pvn[19];
#define LRU_LOADPV(it_) do { const int h_ = (it_) & 15, c_ = ((it_) >> 4) & 15, b_ = (it_) >> 8; const float* pc_ = proj + (size_t)(b_ * SEQ + c_ * 128 + l0 - 3) * INCP + PC_XL + h_ * 64 + lane; \
        _Pragma("unroll") for (int i = 0; i < 19; ++i) pvn[i] = (c_ * 128 + l0 - 3 + i >= 0) ? pc_[(size_t)i * INCP] : 0.f; } while (0)
    LRU_LOADPV(bx);
#pragma unroll 1
    for (int it = bx; it < NIT; it += G) {
        const int h = it & 15, c = (it >> 4) & 15, b = it >> 8, row0 = b * SEQ + c * 128, ch = h * 64 + lane;
        if (h != hcur) {
            hcur = h;
            const float* cw = a.in(I_LCW); w0 = cw[ch]; w1 = cw[WL + ch]; w2 = cw[2 * WL + ch]; w3 = cw[3 * WL + ch]; bb = a.in(I_LCB)[ch];
            const bf16_t* waT = (const bf16_t*)(ws + WS_WAT) + h * 4096; const bf16_t* wiT = (const bf16_t*)(ws + WS_WIT) + h * 4096;
#pragma unroll
            for (int jt = 0; jt < 4; ++jt) { const int cj = h * 64 + jt * 16 + fr; bav[jt] = a.in(I_LBA)[cj]; biv[jt] = a.in(I_LBI)[cj]; sp[jt] = softplusf(-a.in(I_LLAM)[cj]);
#pragma unroll
                for (int kk = 0; kk < 2; ++kk) { ba[jt][kk] = *(const bf16x8*)(waT + (jt * 16 + fr) * 64 + kk * 32 + fq * 8); bi[jt][kk] = *(const bf16x8*)(wiT + (jt * 16 + fr) * 64 + kk * 32 + fq * 8); } }
        }
        float pv[19];
#pragma unroll
        for (int i = 0; i < 19; ++i) pv[i] = pvn[i];
        if (it + G < NIT) LRU_LOADPV(it + G);
#pragma unroll
        for (int i = 0; i < 16; ++i) { const int l = l0 + i;
            const float v = bb + w0 * pv[i] + w1 * pv[i + 1] + w2 * pv[i + 2] + w3 * pv[i + 3];
            s_xc[l * 65 + lane] = v; s_xb[l * 72 + lane] = (bf16_t)f2bf(v); }
        asm volatile("s_waitcnt lgkmcnt(0)" ::: "memory");
        {
            bf16x8 af[2];
#pragma unroll
            for (int kk = 0; kk < 2; ++kk) af[kk] = *(const bf16x8*)(s_xb + (l0 + fr) * 72 + kk * 32 + fq * 8);
#pragma unroll
            for (int jt = 0; jt < 4; ++jt) {
                f32x4 ra = (f32x4){0.f, 0.f, 0.f, 0.f}, ri = ra;
#pragma unroll
                for (int kk = 0; kk < 2; ++kk) { ra = mfma16(af[kk], ba[jt][kk], ra); ri = mfma16(af[kk], bi[jt][kk], ri); }
                const int j = jt * 16 + fr;
#pragma unroll
                for (int i = 0; i < 4; ++i) { const int l = l0 + fq * 4 + i;
                    const float r = sigm(ra[i] + bav[jt]), ig = sigm(ri[i] + biv[jt]);
                    const float la = -8.0f * r * sp[jt]; const float av = __expf(la);
                    const float bt = __builtin_sqrtf(1.f - av * av) * (ig * s_xc[l * 65 + j]);
                    s_a[l * 65 + j] = av; s_b[l * 65 + j] = bt; }
            }
        }
        asm volatile("s_waitcnt lgkmcnt(0)" ::: "memory");
        float sa[16], sb[16];
#pragma unroll
        for (int i = 0; i < 16; ++i) { sa[i] = s_a[(l0 + i) * 65 + lane]; sb[i] = s_b[(l0 + i) * 65 + lane]; }
        float A = 1.f, Bv = 0.f;
#pragma unroll
        for (int i = 0; i < 16; ++i) { A *= sa[i]; Bv = sa[i] * Bv + sb[i]; sa[i] = A; sb[i] = Bv; }
        float* ag = s_ag + par * 1024;
        ag[(wave * 64 + lane) * 2] = A; ag[(wave * 64 + lane) * 2 + 1] = Bv;
        __syncthreads();
        float Ain = 1.f, Bin = 0.f;
        for (int sg = 0; sg < wave; ++sg) { const float As = ag[(sg * 64 + lane) * 2], Bs = ag[(sg * 64 + lane) * 2 + 1]; Bin = As * Bin + Bs; Ain *= As; }
        float ac = 0.f, hl = 0.f;
#pragma unroll
        for (int i = 0; i < 16; ++i) { ac = Ain * sa[i]; hl = sa[i] * Bin + sb[i];
            acum[(size_t)(row0 + l0 + i) * 1024 + ch] = (bf16_t)f2bf(ac); hloc[(size_t)(row0 + l0 + i) * 1024 + ch] = (bf16_t)f2bf(hl); }
        if (wave == 7) { ((float*)(ws + WS_AGA))[(b * NCH + c) * 1024 + ch] = ac; ((float*)(ws + WS_AGB))[(b * NCH + c) * 1024 + ch] = hl; }
        par ^= 1;
    }
    __syncthreads();
#undef LRU_LOADPV
}

__device__ __forceinline__ void ssd_sample(const AP& a, unsigned char* lds, int item, int lane, int wave) {
    const int h = item & 15, b = item >> 4, g = h >> 3;
    unsigned char* ws = a.ws();
    const float* prow = (const float*)(ws + WS_BIG) + (size_t)(TP + b) * INCP;
    float* s_v = (float*)(lds + wave * 16384);
    f32x4 hvs[2][16];
    { const float* h0e = a.in(I_SSM) + (size_t)(b * NH + h) * (HP * NST) + (lane >> 5) * NST + (lane & 31) * 4;
#pragma unroll
      for (int i = 0; i < 32; ++i) hvs[i >> 4][i & 15] = __builtin_nontemporal_load((const f32x4*)(h0e + (size_t)i * 2 * NST)); }
    {
        const float* cw = a.in(I_SCW); const float* cb = a.in(I_SCB); const float* stc = a.in(I_SSC) + (size_t)b * 3 * CONVD;
#pragma unroll
        for (int q = 0; q < 5; ++q) {
            const int lc = q * 64 + lane;
            const int xcol = q == 0 ? h * 64 + lc : (q < 3 ? 1024 + g * 128 + (lc - 64) : 1280 + g * 128 + (lc - 192));
            const float v = cb[xcol] + cw[xcol] * stc[xcol] + cw[CONVD + xcol] * stc[CONVD + xcol] + cw[2 * CONVD + xcol] * stc[2 * CONVD + xcol] + cw[3 * CONVD + xcol] * prow[PC_XBC + xcol];
            s_v[lc] = siluf(v);
        }
        s_v[320 + lane] = bf2f(((const bf16_t*)(ws + WS_ZB))[(size_t)(TP + b) * 1024 + h * 64 + lane]);
    }
    const float dt = softplusf(prow[PC_DT + h] + a.in(I_DTB)[h]);
    const float dA = expf(dt * -expf(a.in(I_ALOG)[h])), Dh = a.in(I_SD)[h];
    asm volatile("s_waitcnt lgkmcnt(0)" ::: "memory");
    const int n4 = (lane & 31) * 4, ph = lane >> 5;
    f32x4 Bv, Cv;
#pragma unroll
    for (int j = 0; j < 4; ++j) { Bv[j] = s_v[64 + n4 + j]; Cv[j] = s_v[192 + n4 + j]; }
    const float* h0 = a.in(I_SSM) + (size_t)(b * NH + h) * (HP * NST) + ph * NST + n4;
    float* ho = a.out() + O_SSMS + (size_t)(b * NH + h) * (HP * NST) + ph * NST + n4;
    bf16_t* a2row = (bf16_t*)(ws + WS_H) + (size_t)(TP + b) * D + h * 64; const float* gnh = a.in(I_SNG) + h * 64;
    float ssq = 0.f;
#pragma unroll
    for (int half = 0; half < 2; ++half) {
#pragma unroll
        for (int i = 0; i < 16; ++i) {
            const int p = (half * 16 + i) * 2 + ph;
            const float xv = s_v[p], xdt = xv * dt;
            const f32x4 hn = hvs[half][i] * dA + Bv * xdt;
            __builtin_nontemporal_store(hn, (f32x4*)(ho + (size_t)(half * 16 + i) * 2 * NST));
            float yp = (hn.x * Cv.x + hn.y * Cv.y) + (hn.z * Cv.z + hn.w * Cv.w);
            yp += __shfl_xor(yp, 1); yp += __shfl_xor(yp, 2); yp += __shfl_xor(yp, 4); yp += __shfl_xor(yp, 8); yp += __shfl_xor(yp, 16);
            if ((lane & 31) == 0) { const float yg = (yp + Dh * xv) * siluf(s_v[320 + p]); a2row[p] = (bf16_t)f2bf(yg * gnh[p]); ssq += yg * yg; }
        }
    }
    ssq += __shfl_xor(ssq, 32);
    if (lane == 0) __hip_atomic_fetch_add((float*)(ws + WS_RSSQ) + TP + b, ssq, __ATOMIC_RELAXED, __HIP_MEMORY_SCOPE_AGENT);
    asm volatile("s_waitcnt lgkmcnt(0)" ::: "memory");
}

__device__ __forceinline__ void lru_sample(const AP& a, unsigned char* lds, int item, int tid, int lane, int wave) {
    const int P = item * 8 + wave, b = P >> 4, h = P & 15, j = lane, ch = h * 64 + j;
    unsigned char* ws = a.ws();
    const float* prow = (const float*)(ws + WS_BIG) + (size_t)(TP + b) * INCP;
    float* s_x = (float*)lds;
    const float* cw = a.in(I_LCW); const float* stc = a.in(I_SLC) + (size_t)b * 3 * WL;
    const float xc = a.in(I_LCB)[ch] + cw[ch] * stc[ch] + cw[WL + ch] * stc[WL + ch] + cw[2 * WL + ch] * stc[2 * WL + ch] + cw[3 * WL + ch] * prow[PC_XL + ch];
    s_x[tid] = xc;
    __syncthreads();
    const float* wa = a.in(I_LWA) + h * 4096 + j; const float* wi = a.in(I_LWI) + h * 4096 + j;
    float ra = a.in(I_LBA)[ch], ri = a.in(I_LBI)[ch];
#pragma unroll 32
    for (int i = 0; i < 64; ++i) { const float xv = s_x[wave * 64 + i]; ra += xv * wa[i * 64]; ri += xv * wi[i * 64]; }
    const float r = sigm(ra), ig = sigm(ri), sp = softplusf(-a.in(I_LLAM)[ch]);
    const float la = -8.0f * r * sp, av = expf(la), bt = sqrtf(-expm1f(2.f * la)) * (ig * xc);
    const float hn = av * a.in(I_SLH)[(size_t)b * WL + ch] + bt;
    a.out()[O_LHS + (size_t)b * WL + ch] = hn;
    ((bf16_t*)(ws + WS_H))[(size_t)(TP + b) * D + 1024 + ch] = (bf16_t)f2bf(hn * gelu_tanh(bf2f(((const bf16_t*)(ws + WS_GLB))[(size_t)(TP + b) * 1024 + ch])));
    __syncthreads();
}

__device__ __forceinline__ void conv_state_out(const AP& a, int gtid, int gthreads) {
    const float* proj = (const float*)(a.ws() + WS_BIG);
    for (int e = gtid; e < NB * 3 * WL; e += gthreads) { const int ch = e % WL, k = (e / WL) % 3, b = e / (3 * WL); a.out()[O_LCP + e] = proj[(size_t)(b * SEQ + SEQ - 3 + k) * INCP + PC_XL + ch]; }
    for (int e = gtid; e < NB * 3 * CONVD; e += gthreads) { const int ch = e % CONVD, k = (e / CONVD) % 3, b = e / (3 * CONVD); a.out()[O_SCP + e] = proj[(size_t)(b * SEQ + SEQ - 3 + k) * INCP + PC_XBC + ch]; }
    for (int e = gtid; e < NS * 3 * WL; e += gthreads) { const int ch = e % WL, k = (e / WL) % 3, b = e / (3 * WL);
        a.out()[O_LCS + e] = k < 2 ? a.in(I_SLC)[(size_t)(b * 3 + k + 1) * WL + ch] : proj[(size_t)(TP + b) * INCP + PC_XL + ch]; }
    for (int e = gtid; e < NS * 3 * CONVD; e += gthreads) { const int ch = e % CONVD, k = (e / CONVD) % 3, b = e / (3 * CONVD);
        a.out()[O_SCS + e] = k < 2 ? a.in(I_SSC)[(size_t)(b * 3 + k + 1) * CONVD + ch] : proj[(size_t)(TP + b) * INCP + PC_XBC + ch]; }
}

__device__ __forceinline__ void ssd_pass2(const AP& a, unsigned char* lds, int item, int tid, int lane, int wave) {
    const int h = item & 15, cq = (item >> 4) & 3, b = item >> 6, g = h >> 3;
    unsigned char* ws = a.ws();
    bf16_t* sC = (bf16_t*)lds; bf16_t* sH = (bf16_t*)(lds + 34816); float* s_cs = (float*)(lds + 52224);
    const float* stb = (const float*)(ws + WS_ST) + (size_t)(b * NCH * NH + h) * (HP * NST);
    const float* cd = (const float*)(ws + WS_CD) + b * NCH * 16 + h;
    f32x4 hv[4];
#pragma unroll
    for (int q = 0; q < 4; ++q) hv[q] = (f32x4){0.f, 0.f, 0.f, 0.f};
#pragma unroll 1
    for (int cp = 0; cp < 4 * cq; cp += 8) {
        f32x4 sv[8][4]; float dec[8]; const bool two = cp + 4 < 4 * cq;
#pragma unroll
        for (int u = 0; u < 8; ++u) { if (u < 4 || two) { dec[u] = cd[(cp + u) * 16]; const float* sp = stb + (size_t)(cp + u) * (NH * HP * NST);
#pragma unroll
            for (int q = 0; q < 4; ++q) sv[u][q] = *(const f32x4*)(sp + (q * 512 + tid) * 4); } }
#pragma unroll
        for (int u = 0; u < 8; ++u) { if (u < 4 || two) {
#pragma unroll
            for (int q = 0; q < 4; ++q) hv[q] = hv[q] * dec[u] + sv[u][q]; } }
    }
    const int fr = lane & 15, fq = lane >> 4;
    float* ypart = (float*)(ws + WS_YPART); const bf16_t* xs_g = (const bf16_t*)(ws + WS_XS); const bf16_t* zb = (const bf16_t*)(ws + WS_ZB);
    const bf16_t* cact2 = (const bf16_t*)(ws + WS_CACT2);
    const float Dh = a.in(I_SD)[h];
    bf16_t* A2 = (bf16_t*)(ws + WS_H); float gnv[4];
#pragma unroll
    for (int pt = 0; pt < 4; ++pt) gnv[pt] = a.in(I_SNG)[h * 64 + pt * 16 + fr];
    u32x4 ct[4]; float csv = 0.f; f32x4 stv[4]; float dec = 0.f;
#define SSD2_LOADSTEP(c_) do { const int r0_ = b * SEQ + (c_) * 128; \
        _Pragma("unroll") for (int q = 0; q < 4; ++q) { const int e = q * 512 + tid, l = e >> 4, k8 = (e & 15) * 8; ct[q] = *(const u32x4*)(cact2 + (size_t)(r0_ + l) * 256 + g * 128 + k8); } \
        if (tid < 128) csv = ((const float*)(ws + WS_CS))[(size_t)(r0_ + tid) * 16 + h]; \
        dec = cd[(c_) * 16]; { const float* sp = stb + (size_t)(c_) * (NH * HP * NST); _Pragma("unroll") for (int q = 0; q < 4; ++q) stv[q] = *(const f32x4*)(sp + (q * 512 + tid) * 4); } } while (0)
    SSD2_LOADSTEP(cq * 4);
#pragma unroll 1
    for (int cc = 0; cc < 4; ++cc) {
        const int c = cq * 4 + cc, row0 = b * SEQ + c * 128;
#pragma unroll
        for (int q = 0; q < 4; ++q) { const int e = (q * 512 + tid) * 4, p = e >> 7, n = e & 127; u32x2 o; o.x = pk2(hv[q].x, hv[q].y); o.y = pk2(hv[q].z, hv[q].w); *(u32x2*)(sH + p * LD + n) = o; }
#pragma unroll
        for (int q = 0; q < 4; ++q) { const int e = q * 512 + tid, l = e >> 4, k8 = (e & 15) * 8; *(u32x4*)(sC + l * LD + k8) = ct[q]; }
        if (tid < 128) s_cs[tid] = csv;
        f32x4 stc[4]; const float decc = dec;
#pragma unroll
        for (int q = 0; q < 4; ++q) stc[q] = stv[q];
        float yp[4][4]; unsigned xz[4][4];
#pragma unroll
        for (int pt = 0; pt < 4; ++pt)
#pragma unroll
            for (int i = 0; i < 4; ++i) { const size_t row = (size_t)(row0 + wave * 16 + fq * 4 + i); const int col = h * 64 + pt * 16 + fr;
                yp[pt][i] = ypart[row * 1024 + col]; xz[pt][i] = (unsigned)xs_g[row * 1024 + col] | ((unsigned)zb[row * 1024 + col] << 16); }
        if (cc < 3) SSD2_LOADSTEP(c + 1);
        __syncthreads();
        bf16x8 af[4];
#pragma unroll
        for (int kk = 0; kk < 4; ++kk) af[kk] = *(const bf16x8*)(sC + (wave * 16 + fr) * LD + kk * 32 + fq * 8);
        float ssq[4] = {0.f, 0.f, 0.f, 0.f};
#pragma unroll
        for (int pt = 0; pt < 4; ++pt) {
            f32x4 y = (f32x4){0.f, 0.f, 0.f, 0.f};
#pragma unroll
            for (int kk = 0; kk < 4; ++kk) { const bf16x8 bh = *(const bf16x8*)(sH + (pt * 16 + fr) * LD + kk * 32 + fq * 8); y = mfma16(af[kk], bh, y); }
#pragma unroll
            for (int i = 0; i < 4; ++i) { const int l = wave * 16 + fq * 4 + i; const size_t row = (size_t)(row0 + l); const int col = h * 64 + pt * 16 + fr;
                const float yv = __expf(s_cs[l]) * y[i] + yp[pt][i] + Dh * bf2f(xz[pt][i] & 0xffffu);
                const float yg = yv * siluf(bf2f(xz[pt][i] >> 16));
                A2[row * D + col] = (bf16_t)f2bf(yg * gnv[pt]); ssq[i] += yg * yg; }
        }
#pragma unroll
        for (int i = 0; i < 4; ++i) { float sq = ssq[i]; sq += __shfl_xor(sq, 1); sq += __shfl_xor(sq, 2); sq += __shfl_xor(sq, 4); sq += __shfl_xor(sq, 8);
            if (fr == 0) __hip_atomic_fetch_add((float*)(ws + WS_RSSQ) + row0 + wave * 16 + fq * 4 + i, sq, __ATOMIC_RELAXED, __HIP_MEMORY_SCOPE_AGENT); }
#pragma unroll
        for (int q = 0; q < 4; ++q) hv[q] = hv[q] * decc + stc[q];
        if (c == NCH - 1) { float* o = a.out() + O_SSMP + (size_t)(b * NH + h) * (HP * NST);
#pragma unroll
            for (int q = 0; q < 4; ++q) *(f32x4*)(o + (q * 512 + tid) * 4) = hv[q]; }
        __syncthreads();
    }
#undef SSD2_LOADSTEP
}

__device__ __forceinline__ void lru_pass2(const AP& a, int item, int tid) {
    const int seg = item & 7, c = (item >> 3) & 15, b = item >> 7;
    unsigned char* ws = a.ws();
    const int ch = tid * 2;
    const float* aga = (const float*)(ws + WS_AGA) + (size_t)b * NCH * 1024 + ch; const float* agb = (const float*)(ws + WS_AGB) + (size_t)b * NCH * 1024 + ch;
    const bf16_t* acum = (const bf16_t*)(ws + WS_ACUM); const bf16_t* hloc = (const bf16_t*)(ws + WS_HLOC); const bf16_t* glb = (const bf16_t*)(ws + WS_GLB);
    bf16_t* A2 = (bf16_t*)(ws + WS_H);
    const int row0 = b * SEQ + c * 128 + seg * 16;
    f32x2 Av[15], Bv[15];
#pragma unroll
    for (int cp = 0; cp < 15; ++cp) { Av[cp] = *(const f32x2*)(aga + cp * 1024); Bv[cp] = *(const f32x2*)(agb + cp * 1024); }
    unsigned acp[16], hlp[16], glp[16];
#pragma unroll
    for (int i = 0; i < 16; ++i) { const size_t row = (size_t)(row0 + i);
        acp[i] = *(const unsigned*)(acum + row * 1024 + ch); hlp[i] = *(const unsigned*)(hloc + row * 1024 + ch); glp[i] = *(const unsigned*)(glb + row * 1024 + ch); }
    f32x2 Hin = (f32x2){0.f, 0.f};
#pragma unroll
    for (int cp = 0; cp < 15; ++cp) { const f32x2 hn = Av[cp] * Hin + Bv[cp]; Hin = cp < c ? hn : Hin; }
#pragma unroll
    for (int i = 0; i < 16; ++i) { const size_t row = (size_t)(row0 + i);
        const f32x2 ac = (f32x2){bf2f(acp[i] & 0xffffu), bf2f(acp[i] >> 16)}, hl = (f32x2){bf2f(hlp[i] & 0xffffu), bf2f(hlp[i] >> 16)}, gl = (f32x2){bf2f(glp[i] & 0xffffu), bf2f(glp[i] >> 16)};
        const f32x2 hv = ac * Hin + hl;
        *(unsigned*)(A2 + row * D + 1024 + ch) = pk2(hv.x * gelu_tanh(gl.x), hv.y * gelu_tanh(gl.y));
        if (c == NCH - 1 && seg == 7 && i == 15) *(f32x2*)(a.out() + O_LHP + (size_t)b * WL + ch) = hv; }
}

__device__ __forceinline__ void ssd_norm(const AP& a, int gw, int NGW, int lane) {
    unsigned char* ws = a.ws();
    const float* ssq = (const float*)(ws + WS_SSQ); bf16_t* A2 = (bf16_t*)(ws + WS_H);
    for (int row = gw; row < MV; row += NGW) {
        u32x4 v[2];
#pragma unroll
        for (int j = 0; j < 2; ++j) v[j] = *(const u32x4*)(A2 + (size_t)row * D + 1024 + (64 * j + lane) * 8);
        float s = lane < 16 ? ssq[(size_t)row * 16 + lane] : 0.f; s = wave_sum(s);
        const float rstd = rsqrtf(s * (1.f / 1024.f) + EPS);
#pragma unroll
        for (int j = 0; j < 2; ++j) { u32x4 o;
#pragma unroll
            for (int q = 0; q < 4; ++q) o[q] = pk2(bf2f(v[j][q] & 0xffffu) * rstd, bf2f(v[j][q] >> 16) * rstd);
            *(u32x4*)(A2 + (size_t)row * D + 1024 + (64 * j + lane) * 8) = o; }
    }
}

#define LAS __attribute__((address_space(3)))
#define XB_TMO      128
#define XB_XCNT(j)  (256  + 64 * (j))
#define XB_XSUB(j)  (1280 + 64 * (j))
#define XB_XGEN(j)  (2304 + 64 * (j))
#define XB_TOP      3328
#define XB_TOPGEN   3392
#define XCD_BAR_WORDS 3456
#define XB_SPIN_CAP (1u << 18)
__device__ __forceinline__ unsigned xb_ld(unsigned* p)              { return __hip_atomic_load(p, __ATOMIC_RELAXED, __HIP_MEMORY_SCOPE_AGENT); }
__device__ __forceinline__ unsigned xb_add(unsigned* p, unsigned v) { return __hip_atomic_fetch_add(p, v, __ATOMIC_RELAXED, __HIP_MEMORY_SCOPE_AGENT); }
__device__ __forceinline__ unsigned xb_xcc_id() { return (unsigned)__builtin_amdgcn_s_getreg((3 << 11) | 20) & 0xFu; }
#define XB_SPIN(cond, bar) do { unsigned _sp = 0; while (cond) { __builtin_amdgcn_s_sleep(1); \
    if ((++_sp & 255u) == 0u) { if (xb_ld(&(bar)[XB_TMO])) break; if (_sp > XB_SPIN_CAP) { atomicAdd(&(bar)[XB_TMO], 1u); break; } } } } while (0)
struct XcdBarrier { unsigned* bar; unsigned x; volatile LAS unsigned* st; };
__device__ __forceinline__ XcdBarrier xcd_barrier_post(unsigned* bar, volatile LAS unsigned* st) {
    XcdBarrier b; b.bar = bar; b.x = xb_xcc_id(); b.st = st;
    if (threadIdx.x == 0) (void)xb_add(&bar[XB_XCNT(b.x)], 1u);
    return b;
}
__device__ __forceinline__ void xcd_barrier_complete(unsigned* bar, unsigned x, unsigned& nloc, unsigned& nx) {
    const unsigned G = gridDim.x * gridDim.y * gridDim.z;
    unsigned sum, cnt, mine, sp = 0u;
    for (;;) {
        sum = 0u; cnt = 0u; mine = 0u;
#pragma unroll
        for (unsigned j = 0; j < 16; ++j) { const unsigned c = xb_ld(&bar[XB_XCNT(j)]); sum += c; cnt += (c > 0u) ? 1u : 0u; mine = (j == x) ? c : mine; }
        if (sum == G) break;
        __builtin_amdgcn_s_sleep(1);
        if ((++sp & 255u) == 0u) { if (xb_ld(&bar[XB_TMO])) break; if (sp > XB_SPIN_CAP) { atomicAdd(&bar[XB_TMO], 1u); break; } }
    }
    nloc = mine > 0u ? mine : 1u; nx = cnt > 0u ? cnt : 1u;
}
__device__ __forceinline__ void xcd_barrier(const XcdBarrier& b) {
    asm volatile("s_waitcnt vmcnt(0)" ::: "memory");
    __syncthreads();
    if (threadIdx.x == 0) {
        unsigned* bar = b.bar;
        __builtin_amdgcn_s_waitcnt(0);
        unsigned nloc = b.st[0], nx = b.st[1];
        if (nloc == 0u) { xcd_barrier_complete(bar, b.x, nloc, nx); b.st[0] = nloc; b.st[1] = nx; }
        const unsigned old = xb_add(&bar[XB_XSUB(b.x)], 1u);
        const unsigned gen = old / nloc;
        if (old + 1u == (gen + 1u) * nloc) {
            __builtin_amdgcn_fence(__ATOMIC_RELEASE, "agent");
            asm volatile("s_waitcnt vmcnt(0)" ::: "memory");
            const unsigned og = xb_add(&bar[XB_TOP], 1u);
            const unsigned tg = og / nx;
            if (og + 1u == (tg + 1u) * nx) xb_add(&bar[XB_TOPGEN], 1u);
            else XB_SPIN(xb_ld(&bar[XB_TOPGEN]) == tg, bar);
            __builtin_amdgcn_fence(__ATOMIC_ACQUIRE, "agent");
            xb_add(&bar[XB_XGEN(b.x)], 1u);
            asm volatile("s_waitcnt vmcnt(0)" ::: "memory");
        } else {
            XB_SPIN(xb_ld(&bar[XB_XGEN(b.x)]) == gen, bar);
            __builtin_amdgcn_fence(__ATOMIC_ACQUIRE, "agent");
            asm volatile("s_waitcnt vmcnt(0)" ::: "memory");
        }
    }
    __syncthreads();
}

constexpr int LDS_BYTES = 147456;
__global__ void __launch_bounds__(512, 2) hymba_fwd(Args kargs) {
    extern __shared__ __attribute__((aligned(16))) unsigned char lds[];
    cg::grid_group grid = cg::this_grid();
    const int G = gridDim.x, bx = blockIdx.x, NGW = G * 8;
#define TIDS() int tid = threadIdx.x; asm volatile("" : "+v"(tid)); const int lane = tid & 63, wave = __builtin_amdgcn_readfirstlane(tid >> 6), gw = bx * 8 + wave; (void)lane; (void)gw
    {   TIDS();
        const unsigned long long* ka = (const unsigned long long*)__builtin_amdgcn_kernarg_segment_ptr();
        if (tid < 37) ((unsigned long long*)(lds + ARGTAB_OFF))[tid] = ka[tid];
        __syncthreads();
    }
    AP a; a.tab = (const unsigned*)(lds + ARGTAB_OFF);
    volatile LAS unsigned* bst = (volatile LAS unsigned*)(lds + 131072 + 512);
    {   TIDS();
        if (tid == 0) { bst[0] = 0u; bst[1] = 0u; }
        if (kargs.never) grid.sync();
        (void)xcd_barrier_post((unsigned*)(a.ws() + WS_CTL), bst);
    }
#define GBAR() do { XcdBarrier xb_; xb_.bar = (unsigned*)(a.ws() + WS_CTL); xb_.x = xb_xcc_id(); xb_.st = bst; xcd_barrier(xb_); } while (0)
#define WSP(T, off) ((T*)(a.ws() + (off)))
    PG8_LAS unsigned char* ldsl = (PG8_LAS unsigned char*)lds;

    { TIDS(); phase0(a, lds, gw, NGW, lane, wave); }
    GBAR();
    { pg8::Gemm g{WSP(const bf16_t, WS_CACT), WSP(const bf16_t, WS_ADA), D, D, 1024}; ModSplitOrder S{G, bx};
      EpiMod E{WSP(float, WS_MOD), a.in(I_BADA), a.in(I_BADAF)}; pg8::gemm_phase(ldsl, g, S, E); }
    { TIDS(); if (bx >= 176) convert_part(a, lds, 3, (bx - 176) * 8 + wave, (G - 176) * 8, lane, wave); }
    { TIDS(); unsigned* fl = WSP(unsigned, WS_CTL) + 3648;
      if (bx < 176 && (bx % 88) < 16) { asm volatile("s_waitcnt vmcnt(0)" ::: "memory"); __syncthreads();
          if (tid == 0) { __builtin_amdgcn_fence(__ATOMIC_RELEASE, "agent"); asm volatile("s_waitcnt vmcnt(0)" ::: "memory"); __hip_atomic_fetch_add(fl, 1u, __ATOMIC_RELAXED, __HIP_MEMORY_SCOPE_AGENT); } }
      if (tid == 0) { unsigned sp = 0; while (__hip_atomic_load(fl, __ATOMIC_RELAXED, __HIP_MEMORY_SCOPE_AGENT) < 32u) { __builtin_amdgcn_s_sleep(4); if (++sp > (1u << 22)) break; } }
      __syncthreads(); }
    { TIDS(); norm1_prompt(a.in(I_XP), a.in(I_GF1), WSP(const float, WS_MOD), 0 * D, 1 * D, WSP(bf16_t, WS_H), gw, NGW, lane);
      norm_phase<false>(a.in(I_XP), a.in(I_XS), nullptr, 0, nullptr, a.in(I_GF1), WSP(const float, WS_MOD), 0 * D, 1 * D, WSP(bf16_t, WS_H), nullptr, nullptr, gw, NGW, lane, TP); }
    GBAR();
    { pg8::Gemm g{WSP(const bf16_t, WS_H), WSP(const bf16_t, WS_WUP1), D, D, D}; pg8::StaticOrder S; S.init(MP / 256, 2 * FF / 256, G, bx); EpiSwiGLU E{WSP(bf16_t, WS_BIG)}; pg8::gemm_phase(ldsl, g, S, E); }
    { TIDS(); convert_in_tail(a, lds, 1, (MP / 256) * (2 * FF / 256), bx, G, lane, wave); }
    GBAR();
    { pg8::Gemm g{WSP(const bf16_t, WS_BIG), WSP(const bf16_t, WS_WDN1), FF, FF, FF}; pg8::StaticOrder S; S.init(TP / 256, D / 256, G, bx);
      EpiResNorm<false> E{a.in(I_XP), WSP(float, WS_X), WSP(const float, WS_MOD), 2 * D, 0.5f, a.in(I_GMIX), 3 * D, 4 * D, WSP(bf16_t, WS_H), nullptr, WSP(float, WS_RS), WSP(unsigned, WS_RS + 32768)}; pg8::gemm_phase(ldsl, g, S, E); }
    { pg8::Gemm g{WSP(const bf16_t, WS_BIG), WSP(const bf16_t, WS_WDN1), FF, FF, KSPL}; SampleSplitOrder S; S.init(FF / KSPL, KSPL, G, bx);
      EpiPart E{WSP(float, WS_PART), WSP(const float, WS_MOD) + 2 * D, 0.5f, KSPL}; pg8::gemm_phase(ldsl, g, S, E); }
    GBAR();
#define SAMPLE_NORM_THEN_FLAG(FLAGW, ...) do { if (bx >= 240) { TIDS(); norm_phase<false>(__VA_ARGS__, (bx - 240) * 8 + wave, 128, lane, TP); \
        asm volatile("s_waitcnt vmcnt(0)" ::: "memory"); __syncthreads(); \
        if (tid == 0) { __builtin_amdgcn_fence(__ATOMIC_RELEASE, "agent"); asm volatile("s_waitcnt vmcnt(0)" ::: "memory"); __hip_atomic_fetch_add(WSP(unsigned, WS_CTL) + (FLAGW), 1u, __ATOMIC_RELAXED, __HIP_MEMORY_SCOPE_AGENT); } } } while (0)
    SAMPLE_NORM_THEN_FLAG(3520, WSP(const float, WS_X), a.in(I_XS), WSP(const float, WS_PART), FF / KSPL, WSP(float, WS_X), a.in(I_GMIX), WSP(const float, WS_MOD), 3 * D, 4 * D, WSP(bf16_t, WS_H), nullptr, nullptr);
    { pg8::Gemm g{WSP(const bf16_t, WS_H), WSP(const bf16_t, WS_WIN), D, D, D}; pg8::StaticOrder S; S.init(MP / 256, INCP / 256, G, bx, WSP(unsigned, WS_CTL) + 3520, 16u);
      EpiProj E{WSP(float, WS_BIG), WSP(bf16_t, WS_GLB), WSP(bf16_t, WS_ZB)}; pg8::gemm_phase(ldsl, g, S, E); }
    { TIDS(); convert_in_tail(a, lds, 2, (MP / 256) * (INCP / 256), bx, G, lane, wave); }
    GBAR();
    { TIDS();
#define M1_SAMPLE_SSD() do { for (int it = gw; it < NS * NH; it += NGW) ssd_sample(a, lds, it, lane, wave); __syncthreads(); } while (0)
    const int slot = bx & 3;
    if (slot == 0) M1_SAMPLE_SSD();
    for (int it = bx; it < NB * NCH * 4; it += G) ssd_pass1(a, lds, it, tid, lane, wave);
    if (slot == 1) M1_SAMPLE_SSD();
    lru_pass1_all(a, lds, bx, G, lane, wave);
    if (slot == 2) M1_SAMPLE_SSD();
    for (int it = bx; it < NS * NH / 8; it += G) lru_sample(a, lds, it, tid, lane, wave);
    if (slot == 3) M1_SAMPLE_SSD();
    conv_state_out(a, bx * 512 + tid, G * 512); }
    GBAR();
    { TIDS();
    for (int it = bx; it < NB * 4 * NH; it += G) ssd_pass2(a, lds, it, tid, lane, wave);
    for (int it = bx; it < NB * NCH * 8; it += G) lru_pass2(a, it, tid); }
    GBAR();
    { pg8::Gemm g{WSP(const bf16_t, WS_H), WSP(const bf16_t, WS_WOUT), D, D, D}; pg8::StaticOrder S; S.init(TP / 256, D / 256, G, bx);
      float* X = WSP(float, WS_X); EpiResNorm<false, true> E{X, X, WSP(const float, WS_MOD), 5 * D, 1.0f, a.in(I_GF2), 6 * D, 7 * D, WSP(bf16_t, WS_H), nullptr, WSP(float, WS_RS + 40960), WSP(unsigned, WS_RS + 40960 + 32768)}; pg8::gemm_phase(ldsl, g, S, E); }
    { pg8::Gemm g{WSP(const bf16_t, WS_H), WSP(const bf16_t, WS_WOUT), D, D, KSPL}; SampleSplitOrder S; S.init(D / KSPL, KSPL, G, bx);
      EpiPart E{WSP(float, WS_PART), WSP(const float, WS_MOD) + 5 * D, 1.0f, KSPL, 1}; pg8::gemm_phase(ldsl, g, S, E); }
    GBAR();
    SAMPLE_NORM_THEN_FLAG(3584, WSP(const float, WS_X), WSP(const float, WS_X) + (size_t)TP * D, WSP(const float, WS_PART), D / KSPL, WSP(float, WS_X), a.in(I_GF2), WSP(const float, WS_MOD), 6 * D, 7 * D, WSP(bf16_t, WS_H), nullptr, nullptr);
    { pg8::Gemm g{WSP(const bf16_t, WS_H), WSP(const bf16_t, WS_WUP2), D, D, D}; pg8::StaticOrder S; S.init(MP / 256, 2 * FF / 256, G, bx, WSP(unsigned, WS_CTL) + 3584, 16u); EpiSwiGLU E{WSP(bf16_t, WS_BIG)}; pg8::gemm_phase(ldsl, g, S, E); }
    GBAR();
    { pg8::Gemm g{WSP(const bf16_t, WS_BIG), WSP(const bf16_t, WS_WDN2), FF, FF, FF}; pg8::StaticOrder S; S.init(TP / 256, D / 256, G, bx);
      float* X = WSP(float, WS_X); EpiResNorm<true> E{X, X, WSP(const float, WS_MOD), 8 * D, 0.5f, a.in(I_GFIN), 9 * D, 10 * D, nullptr, a.out() + O_YP, WSP(float, WS_RS + 81920), WSP(unsigned, WS_RS + 81920 + 32768)}; pg8::gemm_phase(ldsl, g, S, E); }
    { pg8::Gemm g{WSP(const bf16_t, WS_BIG), WSP(const bf16_t, WS_WDN2), FF, FF, KSPL}; SampleSplitOrder S; S.init(FF / KSPL, KSPL, G, bx);
      EpiPart E{WSP(float, WS_PART), WSP(const float, WS_MOD) + 8 * D, 0.5f, KSPL}; pg8::gemm_phase(ldsl, g, S, E); }
    GBAR();
    { TIDS(); static_assert(FF / KSPL > 8 && FF / KSPL <= 24, "final_sample_norm sums partials k, k+8, k+16"); if (bx < NS) final_sample_norm(a, lds, bx, lane, wave); }
}

extern "C" void kernel_launch(void* const* d_in, const int* in_sizes, int n_in, void* d_out, int out_size, void* d_ws, size_t ws_size, hipStream_t stream) {
    static int grid = 0;
    if (grid == 0) {
        if (n_in != 35 || (size_t)out_size != O_END || ws_size < WS_END) { fprintf(stderr, "kernel_launch: unexpected shapes: n_in %d out %d ws %zu (need %zu)\n", n_in, out_size, ws_size, (size_t)WS_END); grid = -1; return; }
        int dev = 0, cus = 0, per_cu = 0;
        hipGetDevice(&dev); hipDeviceGetAttribute(&cus, hipDeviceAttributeMultiprocessorCount, dev);
        hipFuncSetAttribute((const void*)hymba_fwd, hipFuncAttributeMaxDynamicSharedMemorySize, LDS_BYTES);
        hipOccupancyMaxActiveBlocksPerMultiprocessor(&per_cu, (const void*)hymba_fwd, 512, LDS_BYTES);
        if (per_cu < 1) { fprintf(stderr, "kernel_launch: occupancy query says %d blocks/CU\n", per_cu); grid = -1; return; }
        if (cus != 256) { fprintf(stderr, "kernel_launch: built for a 256-CU device (fused norm epilogues need one 256x256 unit per workgroup), got %d CUs\n", cus); grid = -1; return; }
        grid = cus;
    }
    if (grid < 0) return;
    if (hipMemsetAsync((char*)d_ws + WS_CTL, 0, 16384, stream) != hipSuccess) { fprintf(stderr, "kernel_launch: memset of barrier words failed\n"); return; }
    Args a{};
    for (int i = 0; i < 35; ++i) a.in[i] = (const float*)d_in[i];
    a.out = (float*)d_out; a.ws = (unsigned char*)d_ws;
    void* args[] = {&a};
    hipError_t e = hipLaunchCooperativeKernel((const void*)hymba_fwd, dim3(grid), dim3(512), args, LDS_BYTES, stream);
    if (e != hipSuccess) fprintf(stderr, "cooperative launch failed: %s (grid %d)\n", hipGetErrorString(e), grid);
}
```
